# Optimizing an MI355X kernel written in HIP

```python
import math, functools
import jax, jax.numpy as jnp
from jax import lax
import numpy as np

D_MODEL = 1024
BATCH = 8
SEQ = 2048
DEPTH = 1
DEC_BATCH = 128
DEC_SEQ = 8
PAST_LEN = 16384
PAGE_SIZE = 128

D_MIX = D_MODEL
D_LRU = D_MIX // 2
D_POOL = D_MIX - D_LRU
N_LRU_HEADS = 8
LRU_HEAD_DIM = D_LRU // N_LRU_HEADS
LRU_CONV = 4
LRU_C = 8.0
POOL_WINDOWS = (2, 4, 8, 16)
N_POOL_GROUPS = len(POOL_WINDOWS)
POOL_GROUP_DIM = D_POOL // N_POOL_GROUPS
POOL_BUF = max(POOL_WINDOWS) - 1
D_IN = 2 * D_LRU + D_POOL
D_FF = 3 * D_MODEL
FFN_CONV = 3
EPS = 1e-6

kernel_name = "hymba_style_rglru_pool_convffn_step"


def rmsnorm(x, g):
    xf = x.astype(jnp.float32)
    y = xf * lax.rsqrt(jnp.mean(xf * xf, axis=-1, keepdims=True) + EPS)
    return (y * g.astype(jnp.float32)).astype(x.dtype)


def causal_dwconv(x, buf, w, b):
    k = w.shape[0]
    s = x.shape[1]
    xp = jnp.concatenate([buf.astype(x.dtype), x], axis=1)
    y = xp[:, 0:s] * w[0]
    for j in range(1, k):
        y = y + xp[:, j:j + s] * w[j]
    y = y + b
    new_buf = xp[:, xp.shape[1] - (k - 1):]
    return y, new_buf.astype(buf.dtype)


def rg_lru(x, h0, wa, ba, wx, bx, lam):
    bsz, s, _ = x.shape
    xh = x.reshape(bsz, s, N_LRU_HEADS, LRU_HEAD_DIM)
    r = jax.nn.sigmoid(jnp.einsum('bshi,hij->bshj', xh, wa).reshape(bsz, s, D_LRU) + ba)
    i = jax.nn.sigmoid(jnp.einsum('bshi,hij->bshj', xh, wx).reshape(bsz, s, D_LRU) + bx)
    log_a = -LRU_C * r.astype(jnp.float32) * jax.nn.softplus(-lam.astype(jnp.float32))
    a = jnp.exp(log_a)
    mult = jnp.sqrt(-jnp.expm1(2.0 * log_a))
    bterm = mult * (i * x).astype(jnp.float32)
    bterm = bterm.at[:, 0].add(a[:, 0] * h0.astype(jnp.float32))

    def combine(left, right):
        al, bl = left
        ar, br = right
        return al * ar, ar * bl + br

    _, h = lax.associative_scan(combine, (a, bterm), axis=1)
    return h.astype(x.dtype), h[:, -1].astype(h0.dtype)


def pool_mixer(x, buf, wg, scale, start):
    bsz, s, _ = x.shape
    xp = jnp.concatenate([buf.astype(x.dtype), x], axis=1).astype(jnp.float32)
    cs = jnp.concatenate([jnp.zeros((bsz, 1, D_POOL), jnp.float32), jnp.cumsum(xp, axis=1)], axis=1)
    pos = start + jnp.arange(s)
    xt = xp[:, POOL_BUF:]
    outs = []
    for g, w in enumerate(POOL_WINDOWS):
        c0, c1 = g * POOL_GROUP_DIM, (g + 1) * POOL_GROUP_DIM
        hi = cs[:, POOL_BUF + 1:POOL_BUF + 1 + s, c0:c1]
        lo = cs[:, POOL_BUF + 1 - w:POOL_BUF + 1 - w + s, c0:c1]
        cnt = jnp.minimum(w, pos + 1).astype(jnp.float32)[None, :, None]
        outs.append((hi - lo) / cnt - xt[:, :, c0:c1])
    pooled = jnp.stack(outs, axis=2)
    y = jnp.einsum('bsgi,gij->bsgj', pooled, wg.astype(jnp.float32)).reshape(bsz, s, D_POOL)
    y = y * scale.astype(jnp.float32)
    new_buf = xp[:, xp.shape[1] - POOL_BUF:]
    return y.astype(x.dtype), new_buf.astype(buf.dtype)


def layer(x, lru_buf, h0, pool_buf, ffn_buf, start,
          norm1_g, w_in, lru_conv_w, lru_conv_b, lru_wa, lru_ba, lru_wx, lru_bx, lru_lambda,
          pool_w, pool_scale, w_out, norm2_g, ffn_up, ffn_conv_w, ffn_conv_b, ffn_down):
    h = rmsnorm(x, norm1_g)
    z = jnp.einsum('bsd,de->bse', h, w_in)
    zx = z[..., :D_LRU]
    zg = z[..., D_LRU:2 * D_LRU]
    zp = z[..., 2 * D_LRU:]
    xc, new_lru_buf = causal_dwconv(zx, lru_buf, lru_conv_w, lru_conv_b)
    hl, h_last = rg_lru(xc, h0, lru_wa, lru_ba, lru_wx, lru_bx, lru_lambda)
    lru_out = hl * jax.nn.gelu(zg)
    pool_out, new_pool_buf = pool_mixer(zp, pool_buf, pool_w, pool_scale, start)
    mixed = jnp.concatenate([lru_out, pool_out], axis=-1)
    x = x + jnp.einsum('bse,ed->bsd', mixed, w_out)
    h2 = rmsnorm(x, norm2_g)
    u = jnp.einsum('bsd,df->bsf', h2, ffn_up)
    uc, new_ffn_buf = causal_dwconv(u, ffn_buf, ffn_conv_w, ffn_conv_b)
    gate = uc[..., :D_FF]
    val = uc[..., D_FF:]
    x = x + jnp.einsum('bsf,fd->bsd', jax.nn.gelu(gate) * val, ffn_down)
    return x, new_lru_buf, h_last, new_pool_buf, new_ffn_buf


def setup_inputs(seed: int = 0) -> dict:
    key = jax.random.key(seed)
    ks = jax.random.split(key, 24)
    f32 = jnp.float32
    nrm = lambda k, shape, sc: jax.random.normal(k, shape, f32) * sc
    a0 = jax.random.uniform(ks[13], (DEPTH, D_LRU), f32, minval=0.9, maxval=0.999)
    return {
        "x_prompt": nrm(ks[0], (BATCH, SEQ, D_MODEL), 1.0),
        "x_sample": nrm(ks[1], (DEC_BATCH, DEC_SEQ, D_MODEL), 1.0),
        "state_lru_conv": nrm(ks[2], (DEPTH, DEC_BATCH, LRU_CONV - 1, D_LRU), 1.0),
        "state_lru_h": nrm(ks[3], (DEPTH, DEC_BATCH, D_LRU), 0.5),
        "state_pool": nrm(ks[4], (DEPTH, DEC_BATCH, POOL_BUF, D_POOL), 1.0),
        "state_ffn_conv": nrm(ks[5], (DEPTH, DEC_BATCH, FFN_CONV - 1, 2 * D_FF), 1.0),
        "norm1_g": 1.0 + nrm(ks[6], (DEPTH, D_MODEL), 0.05),
        "w_in": nrm(ks[7], (DEPTH, D_MODEL, D_IN), D_MODEL ** -0.5),
        "lru_conv_w": nrm(ks[8], (DEPTH, LRU_CONV, D_LRU), LRU_CONV ** -0.5),
        "lru_conv_b": nrm(ks[9], (DEPTH, D_LRU), 0.01),
        "lru_wa": nrm(ks[10], (DEPTH, N_LRU_HEADS, LRU_HEAD_DIM, LRU_HEAD_DIM), LRU_HEAD_DIM ** -0.5),
        "lru_ba": nrm(ks[11], (DEPTH, D_LRU), 0.01),
        "lru_wx": nrm(ks[12], (DEPTH, N_LRU_HEADS, LRU_HEAD_DIM, LRU_HEAD_DIM), LRU_HEAD_DIM ** -0.5),
        "lru_bx": nrm(ks[14], (DEPTH, D_LRU), 0.01),
        "lru_lambda": jnp.log(a0) - jnp.log1p(-a0),
        "pool_w": nrm(ks[15], (DEPTH, N_POOL_GROUPS, POOL_GROUP_DIM, POOL_GROUP_DIM), POOL_GROUP_DIM ** -0.5),
        "pool_scale": 0.5 + nrm(ks[16], (DEPTH, D_POOL), 0.05),
        "w_out": nrm(ks[17], (DEPTH, D_MIX, D_MODEL), D_MIX ** -0.5),
        "norm2_g": 1.0 + nrm(ks[18], (DEPTH, D_MODEL), 0.05),
        "ffn_up": nrm(ks[19], (DEPTH, D_MODEL, 2 * D_FF), D_MODEL ** -0.5),
        "ffn_conv_w": nrm(ks[20], (DEPTH, FFN_CONV, 2 * D_FF), FFN_CONV ** -0.5),
        "ffn_conv_b": nrm(ks[21], (DEPTH, 2 * D_FF), 0.01),
        "ffn_down": nrm(ks[22], (DEPTH, D_FF, D_MODEL), D_FF ** -0.5),
        "final_g": 1.0 + nrm(ks[23], (D_MODEL,), 0.05),
    }


def reference(x_prompt, x_sample, state_lru_conv, state_lru_h, state_pool, state_ffn_conv,
              norm1_g, w_in, lru_conv_w, lru_conv_b, lru_wa, lru_ba, lru_wx, lru_bx, lru_lambda,
              pool_w, pool_scale, w_out, norm2_g, ffn_up, ffn_conv_w, ffn_conv_b, ffn_down, final_g):
    dt = x_prompt.dtype
    xp, xs = x_prompt, x_sample
    p_lc, p_h, p_pb, p_fb = [], [], [], []
    s_lc, s_h, s_pb, s_fb = [], [], [], []
    for l in range(DEPTH):
        params = (norm1_g[l], w_in[l], lru_conv_w[l], lru_conv_b[l], lru_wa[l], lru_ba[l],
                  lru_wx[l], lru_bx[l], lru_lambda[l], pool_w[l], pool_scale[l], w_out[l],
                  norm2_g[l], ffn_up[l], ffn_conv_w[l], ffn_conv_b[l], ffn_down[l])
        xp, a1, a2, a3, a4 = layer(
            xp,
            jnp.zeros((BATCH, LRU_CONV - 1, D_LRU), dt),
            jnp.zeros((BATCH, D_LRU), dt),
            jnp.zeros((BATCH, POOL_BUF, D_POOL), dt),
            jnp.zeros((BATCH, FFN_CONV - 1, 2 * D_FF), dt),
            0, *params)
        p_lc.append(a1); p_h.append(a2); p_pb.append(a3); p_fb.append(a4)
        xs, b1, b2, b3, b4 = layer(
            xs, state_lru_conv[l], state_lru_h[l], state_pool[l], state_ffn_conv[l],
            PAST_LEN, *params)
        s_lc.append(b1); s_h.append(b2); s_pb.append(b3); s_fb.append(b4)
    y_prompt = rmsnorm(xp, final_g)
    y_sample = rmsnorm(xs, final_g)
    return (y_prompt, y_sample,
            jnp.stack(p_lc), jnp.stack(p_h), jnp.stack(p_pb), jnp.stack(p_fb),
            jnp.stack(s_lc), jnp.stack(s_h), jnp.stack(s_pb), jnp.stack(s_fb))
```

```cpp
#include <hip/hip_runtime.h>
#include <hip/hip_cooperative_groups.h>
#include <cstdio>
#include <cstdint>
namespace cg = cooperative_groups;

#ifndef MK_N_LAUNCHES
#define MK_N_LAUNCHES 1
#endif

#define LAS __attribute__((address_space(3)))
typedef unsigned short bf16_t;
typedef short bf16x8 __attribute__((ext_vector_type(8)));
typedef float f32x4 __attribute__((ext_vector_type(4)));
typedef float f32x2 __attribute__((ext_vector_type(2)));
typedef unsigned u32x4 __attribute__((ext_vector_type(4)));
typedef unsigned u32x2 __attribute__((ext_vector_type(2)));

constexpr int MP = 16384, MS = 1024, M = MP + MS, D = 1024, DIN = 1536, DL = 512, FF = 3072, FF2 = 6144;
constexpr int ZROWS = MP + 128 * 32;
constexpr int NBLK = 1024 + 128;
constexpr float EPS = 1e-6f;

constexpr size_t O_Y = 0, O_PLC = 17825792, O_PH = 17838080, O_PPOOL = 17842176, O_PFFN = 17903616,
                 O_SLC = 18001920, O_SH = 18198528, O_SPOOL = 18264064, O_SFFN = 19247104;

constexpr size_t MiB = 1u << 20;
constexpr size_t WS_WI = 1 * MiB, WS_WO = 4 * MiB, WS_WU = 6 * MiB, WS_WD = 18 * MiB;
constexpr size_t WS_WA = 24 * MiB, WS_WX = WS_WA + 65536, WS_PW = WS_WX + 65536;
constexpr size_t WS_RS1 = 25 * MiB, WS_RSS2 = WS_RS1 + 131072;
constexpr size_t WS_EDGE = 27 * MiB;
constexpr size_t WS_XB = 34 * MiB;
constexpr size_t WS_MIX = 68 * MiB;
constexpr size_t WS_Z = 102 * MiB;
constexpr size_t WS_HL = 162 * MiB, WS_PP = 202 * MiB;
constexpr size_t WS_ACT = 102 * MiB;
constexpr size_t WS_END = 242 * MiB;

constexpr int LDS_BYTES = 147456;
constexpr int LDS_X = 131072;

__device__ __forceinline__ unsigned cvt_pk_bf16(float lo, float hi) { unsigned r; asm volatile("v_cvt_pk_bf16_f32 %0, %1, %2" : "=v"(r) : "v"(lo), "v"(hi)); return r; }
__device__ __forceinline__ float bf_lo(unsigned u) { return __builtin_bit_cast(float, u << 16); }
__device__ __forceinline__ float bf_hi(unsigned u) { return __builtin_bit_cast(float, u & 0xffff0000u); }
__device__ __forceinline__ float bf_one(bf16_t u) { return __builtin_bit_cast(float, (unsigned)u << 16); }
__device__ __forceinline__ float wave_sum(float v) {
#pragma unroll
    for (int o = 1; o < 64; o <<= 1) v += __shfl_xor(v, o);
    return v;
}
#define DPP_SHR(n) (0x110 + (n))
#define DPP_ROR(n) (0x120 + (n))
template <int CTRL> __device__ __forceinline__ unsigned dppu(unsigned old, unsigned src) { return (unsigned)__builtin_amdgcn_update_dpp((int)old, (int)src, CTRL, 0xf, 0xf, false); }
template <int CTRL> __device__ __forceinline__ float dppf(float old, float src) {
    return __builtin_bit_cast(float, __builtin_amdgcn_update_dpp(__builtin_bit_cast(int, old), __builtin_bit_cast(int, src), CTRL, 0xf, 0xf, false));
}
template <int Dd> __device__ __forceinline__ unsigned shiftu(unsigned prev, unsigned cur) { return dppu<DPP_SHR(Dd)>(dppu<DPP_ROR(Dd)>(0u, prev), cur); }
template <int Dd> __device__ __forceinline__ float shiftf(float prev, float cur) { return dppf<DPP_SHR(Dd)>(dppf<DPP_ROR(Dd)>(0.f, prev), cur); }

__device__ __forceinline__ float sigmoidf_(float x) { return __builtin_amdgcn_rcpf(1.0f + __builtin_amdgcn_exp2f(-1.4426950409f * x)); }
__device__ __forceinline__ float gelu_tanh(float x) {
    const float k = -2.302208198f;
    const float p = x * (k + (k * 0.044715f) * (x * x));
    return x * __builtin_amdgcn_rcpf(1.0f + __builtin_amdgcn_exp2f(p));
}

namespace pg8 {
constexpr int BM = 256, BK = 64, HALF = 128, HTB = HALF * BK * 2, STAGE_BYTES = 8 * HTB, NXCD = 8, WGM = 8;
__host__ __device__ __forceinline__ int lds_byte(int r, int c) { const int st = (r >> 4) * 2 + (c >> 5), rr = r & 15, cc = c & 31, ob = rr * 64 + cc * 2; return st * 1024 + (ob ^ (((ob >> 9) & 1) << 5)); }
__host__ __device__ __forceinline__ void stage_rc(int b, int& R, int& C) { const int st = b / 1024, sb = b % 1024, swz = sb ^ (((sb >> 9) & 1) << 5); R = (st >> 1) * 16 + swz / 64; C = (st & 1) * 32 + (swz % 64) / 2; }
__host__ __device__ __forceinline__ int perm32(int rho) { const int n = rho >> 4, i = rho & 15; return 8 * (i >> 2) + 4 * n + (i & 3); }

struct Unit { int pm, pn; };
struct Gemm { const bf16_t* A; const bf16_t* Bt; int M, N, K; };

struct StaticOrder {
    int nM, nN, nwg, G, c;
    __host__ __device__ void init(int M_, int N_, int G_, int c_) { nM = M_ / BM; nN = N_ / BM; nwg = nM * nN; G = G_; c = c_; }
    __host__ __device__ bool next(int i, Unit& u) const {
        const long L = (long)i * G + c; if (L >= nwg) return false;
        int wgid = (int)L; { const int q = nwg / NXCD, r = nwg % NXCD, xcd = wgid % NXCD, off = wgid / NXCD; wgid = (xcd < r ? xcd * (q + 1) : r * (q + 1) + (xcd - r) * q) + off; }
        const int nig = WGM * nN, gid = wgid / nig, fm = gid * WGM, gsz = (nM - fm) < WGM ? (nM - fm) : WGM;
        u.pm = fm + ((wgid % nig) % gsz); u.pn = (wgid % nig) / gsz; return true;
    }
    __device__ __forceinline__ void a_ready(const Unit&) const {}
    __device__ __forceinline__ void done(const Unit&) const {}
};

template <class Epi, class Sched, bool ALIGN_EPI = false, bool SP2 = false>
__device__ __forceinline__ void gemm_phase(LAS unsigned char* lds, const Gemm g, const Sched& S, const Epi& E) {
    const int tid = threadIdx.x, wid = __builtin_amdgcn_readfirstlane(tid >> 6), lane = tid & 63, wr = wid >> 2, wc = wid & 3, fr = lane & 15, fq = lane >> 4;
    const int K = g.K, nt = K / BK;
    unsigned voffA[2], voffB[2];
#pragma unroll
    for (int i = 0; i < 2; ++i) { int R, C; stage_rc(tid * 16 + i * 8192, R, C); const int Rb = Epi::PERM ? ((R & ~31) + perm32(R & 31)) : R;
        voffA[i] = (unsigned)(R * K + C) * 2u; voffB[i] = (unsigned)(Rb * K + C) * 2u; }
    const size_t kstep = (size_t)(BK * 2);
    const size_t hstep = (size_t)HALF * K * 2;
    const size_t tstep = 2 * hstep;
    const unsigned ldsw = (unsigned)wid * 1024u;
    const int aoff = lds_byte(wr * 64 + fr, fq * 8), boff = lds_byte(wc * 32 + fr, fq * 8);
#define PG8_SA(b, h) (((b) * 2 + (h)) * HTB)
#define PG8_SB(b, h) ((4 + (b) * 2 + (h)) * HTB)
#define PG8_STAGE(bufoff, gbase, voff) do { _Pragma("unroll") for (int _i = 0; _i < 2; ++_i) \
        __builtin_amdgcn_global_load_lds((const unsigned*)((const char*)(gbase) + (voff)[_i]), (LAS unsigned*)(lds + (bufoff) + ldsw + _i * 8192), 16, 0, 0); } while (0)
#define PG8_LDA(dst, b, h) do { _Pragma("unroll") for (int m = 0; m < 4; ++m) _Pragma("unroll") for (int k = 0; k < 2; ++k) dst[m][k] = *(const LAS bf16x8*)(lds + PG8_SA(b, h) + aoff + m * 2048 + k * 1024); } while (0)
#define PG8_LDB(dst, b, h) do { _Pragma("unroll") for (int n = 0; n < 2; ++n) _Pragma("unroll") for (int k = 0; k < 2; ++k) dst[n][k] = *(const LAS bf16x8*)(lds + PG8_SB(b, h) + boff + n * 2048 + k * 1024); } while (0)
#define PG8_MMA(ai, bj, At, Bt) do { __builtin_amdgcn_s_setprio(1); _Pragma("unroll") for (int m = 0; m < 4; ++m) _Pragma("unroll") for (int n = 0; n < 2; ++n) _Pragma("unroll") for (int k = 0; k < 2; ++k) \
        acc[ai][bj][m][n] = __builtin_amdgcn_mfma_f32_16x16x32_bf16(Bt[n][k], At[m][k], acc[ai][bj][m][n], 0, 0, 0); __builtin_amdgcn_s_setprio(0); } while (0)
#define PG8_WAIT_V(n) asm volatile("s_waitcnt vmcnt(" #n ")" ::: "memory")
#define PG8_WAIT_L(n) asm volatile("s_waitcnt lgkmcnt(" #n ")" ::: "memory")
#define PG8_BAR __builtin_amdgcn_s_barrier()
#define PG8_SCHED __builtin_amdgcn_sched_barrier(0)
    Unit cur, nxt; int ui = 0;
    if (!S.next(0, cur)) return;
    f32x4 acc[2][2][4][2];
#pragma unroll
    for (int a = 0; a < 2; ++a)
#pragma unroll
        for (int b = 0; b < 2; ++b)
#pragma unroll
            for (int m = 0; m < 4; ++m)
#pragma unroll
                for (int n = 0; n < 2; ++n) acc[a][b][m][n] = (f32x4){0.f, 0.f, 0.f, 0.f};
    bf16x8 At[4][2], B0[2][2], B1[2][2];
    const char* cA = (const char*)g.A + (size_t)cur.pm * tstep; const char* cB = (const char*)g.Bt + (size_t)cur.pn * tstep;
    S.a_ready(cur);
    if constexpr (SP2) {
        PG8_STAGE(PG8_SB(0, 0), cB, voffB); PG8_STAGE(PG8_SB(0, 1), cB + hstep, voffB); PG8_STAGE(PG8_SA(0, 0), cA, voffA); PG8_STAGE(PG8_SA(0, 1), cA + hstep, voffA);
        if (wr == 1) PG8_BAR;
        PG8_WAIT_V(2); PG8_BAR;
        PG8_STAGE(PG8_SB(1, 0), cB + kstep, voffB); PG8_STAGE(PG8_SA(1, 0), cA + kstep, voffA); PG8_STAGE(PG8_SB(1, 1), cB + hstep + kstep, voffB);
        PG8_WAIT_V(6); PG8_BAR;
    } else {
        PG8_STAGE(PG8_SB(0, 0), cB, voffB); PG8_STAGE(PG8_SA(0, 0), cA, voffA); PG8_STAGE(PG8_SB(0, 1), cB + hstep, voffB); PG8_STAGE(PG8_SA(0, 1), cA + hstep, voffA);
        if (wr == 1) PG8_BAR;
        PG8_WAIT_V(4); PG8_BAR;
        PG8_STAGE(PG8_SB(1, 0), cB + kstep, voffB); PG8_STAGE(PG8_SA(1, 0), cA + kstep, voffA); PG8_STAGE(PG8_SB(1, 1), cB + hstep + kstep, voffB);
        PG8_WAIT_V(6); PG8_BAR;
    }
    for (;;) {
        const bool has_next = S.next(ui + 1, nxt);
        const char* nA = has_next ? (const char*)g.A + (size_t)nxt.pm * tstep : cA; const char* nB = has_next ? (const char*)g.Bt + (size_t)nxt.pn * tstep : cB;
        for (int t = 0; t < nt; t += 2) {
            const bool last = (t == nt - 2);
            const char* a1 = cA + (size_t)(t + 1) * kstep;
            const char* a2 = last ? nA : cA + (size_t)(t + 2) * kstep; const char* b2 = last ? nB : cB + (size_t)(t + 2) * kstep;
            const char* a3 = a2 + kstep; const char* b3 = b2 + kstep;
            if (last && has_next) S.a_ready(nxt);
            if constexpr (SP2) {
            PG8_LDB(B0, 0, 0); PG8_LDB(B1, 0, 1); PG8_SCHED; PG8_LDA(At, 0, 0); PG8_STAGE(PG8_SA(1, 1), a1 + hstep, voffA);
            PG8_WAIT_V(8); PG8_WAIT_L(0); PG8_BAR; PG8_MMA(0, 0, At, B0); PG8_MMA(0, 1, At, B1); PG8_BAR; PG8_SCHED;
            PG8_LDA(At, 0, 1); PG8_STAGE(PG8_SB(0, 0), b2, voffB); PG8_STAGE(PG8_SB(0, 1), b2 + hstep, voffB); PG8_STAGE(PG8_SA(0, 0), a2, voffA);
            PG8_WAIT_V(8); PG8_WAIT_L(0); PG8_BAR; PG8_MMA(1, 0, At, B0); PG8_MMA(1, 1, At, B1); PG8_BAR; PG8_SCHED;
            PG8_LDB(B0, 1, 0); PG8_LDB(B1, 1, 1); PG8_SCHED; PG8_LDA(At, 1, 0); PG8_STAGE(PG8_SA(0, 1), a2 + hstep, voffA);
            PG8_WAIT_V(8); PG8_WAIT_L(0); PG8_BAR; PG8_MMA(0, 0, At, B0); PG8_MMA(0, 1, At, B1); PG8_BAR; PG8_SCHED;
            PG8_LDA(At, 1, 1); PG8_STAGE(PG8_SB(1, 0), b3, voffB); PG8_STAGE(PG8_SB(1, 1), b3 + hstep, voffB); PG8_STAGE(PG8_SA(1, 0), a3, voffA);
            PG8_WAIT_V(8); PG8_WAIT_L(0); PG8_BAR; PG8_MMA(1, 0, At, B0); PG8_MMA(1, 1, At, B1); PG8_BAR; PG8_SCHED;
            } else {
            PG8_LDB(B0, 0, 0); PG8_SCHED; PG8_LDA(At, 0, 0); PG8_STAGE(PG8_SA(1, 1), a1 + hstep, voffA);
            PG8_WAIT_L(8); PG8_BAR; PG8_WAIT_L(0); PG8_MMA(0, 0, At, B0); PG8_BAR; PG8_SCHED;
            PG8_LDB(B1, 0, 1); PG8_STAGE(PG8_SB(0, 0), b2, voffB);
            PG8_BAR; PG8_WAIT_L(0); PG8_MMA(0, 1, At, B1); PG8_BAR;
            PG8_LDA(At, 0, 1); PG8_STAGE(PG8_SA(0, 0), a2, voffA);
            PG8_BAR; PG8_WAIT_L(0); PG8_MMA(1, 0, At, B0); PG8_BAR; PG8_SCHED;
            PG8_STAGE(PG8_SB(0, 1), b2 + hstep, voffB);
            PG8_WAIT_V(6); PG8_BAR; PG8_MMA(1, 1, At, B1); PG8_BAR;
            PG8_LDB(B0, 1, 0); PG8_SCHED; PG8_LDA(At, 1, 0); PG8_STAGE(PG8_SA(0, 1), a2 + hstep, voffA);
            PG8_WAIT_L(8); PG8_BAR; PG8_WAIT_L(0); PG8_MMA(0, 0, At, B0); PG8_BAR; PG8_SCHED;
            PG8_LDB(B1, 1, 1); PG8_STAGE(PG8_SB(1, 0), b3, voffB);
            PG8_BAR; PG8_WAIT_L(0); PG8_MMA(0, 1, At, B1); PG8_BAR;
            PG8_LDA(At, 1, 1); PG8_STAGE(PG8_SA(1, 0), a3, voffA);
            PG8_BAR; PG8_WAIT_L(0); PG8_MMA(1, 0, At, B0); PG8_BAR; PG8_SCHED;
            PG8_STAGE(PG8_SB(1, 1), b3 + hstep, voffB);
            PG8_WAIT_V(6); PG8_BAR; PG8_MMA(1, 1, At, B1); PG8_BAR;
            }
        }
        if constexpr (ALIGN_EPI) { if (wr == 0) PG8_BAR; }
        E(acc, cur, wr, wc, fr, fq); S.done(cur);
        if (!has_next) break;
#pragma unroll
        for (int a = 0; a < 2; ++a)
#pragma unroll
            for (int b = 0; b < 2; ++b)
#pragma unroll
                for (int m = 0; m < 4; ++m)
#pragma unroll
                    for (int n = 0; n < 2; ++n) acc[a][b][m][n] = (f32x4){0.f, 0.f, 0.f, 0.f};
        cur = nxt; cA = nA; cB = nB; ++ui;
        if constexpr (ALIGN_EPI) { if (wr == 1) PG8_BAR; }
    }
    PG8_WAIT_V(0);
    if constexpr (!ALIGN_EPI) { if (wr == 0) PG8_BAR; }
    PG8_BAR;
#undef PG8_SA
#undef PG8_SB
#undef PG8_STAGE
#undef PG8_LDA
#undef PG8_LDB
#undef PG8_MMA
#undef PG8_WAIT_V
#undef PG8_WAIT_L
#undef PG8_BAR
#undef PG8_SCHED
}
}
using pg8::Unit;

struct EpiZ {
    static constexpr bool PERM = true;
    bf16_t* Z; const float* rs1;
    __device__ __forceinline__ void operator()(const f32x4 (&acc)[2][2][4][2], const Unit& u, int wr, int wc, int fr, int fq) const {
        const int row0 = u.pm * 256 + wr * 64 + fr, col0 = u.pn * 256 + wc * 32 + 8 * fq;
#pragma unroll
        for (int ai = 0; ai < 2; ++ai)
#pragma unroll
            for (int m = 0; m < 4; ++m) {
                const int row = row0 + ai * 128 + m * 16; const float s = rs1[row];
                const int orow = row < MP ? row : MP + ((row - MP) >> 3) * 32 + 24 + (row & 7);
                bf16_t* rowp = Z + (size_t)orow * DIN + col0;
#pragma unroll
                for (int bj = 0; bj < 2; ++bj) { const f32x4 v0 = acc[ai][bj][m][0] * s, v1 = acc[ai][bj][m][1] * s;
                    u32x4 w; w.x = cvt_pk_bf16(v0[0], v0[1]); w.y = cvt_pk_bf16(v0[2], v0[3]); w.z = cvt_pk_bf16(v1[0], v1[1]); w.w = cvt_pk_bf16(v1[2], v1[3]);
                    *(u32x4*)(rowp + bj * 128) = w; }
            }
    }
};
struct EpiX1 {
    static constexpr bool PERM = true;
    const float* xp; const float* xs; float* y; bf16_t* X1B; float* rss2;
    __device__ __forceinline__ void operator()(const f32x4 (&acc)[2][2][4][2], const Unit& u, int wr, int wc, int fr, int fq) const {
        const int row0 = u.pm * 256 + wr * 64 + fr, col0 = u.pn * 256 + wc * 32 + 8 * fq;
#pragma unroll
        for (int ai = 0; ai < 2; ++ai)
#pragma unroll
            for (int m = 0; m < 4; ++m) {
                const int row = row0 + ai * 128 + m * 16;
                const float* xr = (row < MP ? xp + (size_t)row * D : xs + (size_t)(row - MP) * D) + col0;
                float* yr = y + (size_t)row * D + col0; bf16_t* br = X1B + (size_t)row * D + col0; float ss = 0.f;
#pragma unroll
                for (int bj = 0; bj < 2; ++bj) { const f32x4 v0 = acc[ai][bj][m][0] + *(const f32x4*)(xr + bj * 128), v1 = acc[ai][bj][m][1] + *(const f32x4*)(xr + bj * 128 + 4);
                    *(f32x4*)(yr + bj * 128) = v0; *(f32x4*)(yr + bj * 128 + 4) = v1;
                    u32x4 w; w.x = cvt_pk_bf16(v0[0], v0[1]); w.y = cvt_pk_bf16(v0[2], v0[3]); w.z = cvt_pk_bf16(v1[0], v1[1]); w.w = cvt_pk_bf16(v1[2], v1[3]);
                    *(u32x4*)(br + bj * 128) = w;
                    ss += (v0[0] * v0[0] + v0[1] * v0[1]) + (v0[2] * v0[2] + v0[3] * v0[3]) + (v1[0] * v1[0] + v1[1] * v1[1]) + (v1[2] * v1[2] + v1[3] * v1[3]); }
                ss += __shfl_xor(ss, 16); ss += __shfl_xor(ss, 32);
                if (fq == 0) rss2[(size_t)row * 16 + u.pn * 4 + wc] = ss;
            }
    }
};
struct EpiX2 {
    static constexpr bool PERM = true;
    float* y;
    __device__ __forceinline__ void operator()(const f32x4 (&acc)[2][2][4][2], const Unit& u, int wr, int wc, int fr, int fq) const {
        const int row0 = u.pm * 256 + wr * 64 + fr, col0 = u.pn * 256 + wc * 32 + 8 * fq;
#pragma unroll
        for (int ai = 0; ai < 2; ++ai)
#pragma unroll
            for (int m = 0; m < 4; ++m) {
                float* yr = y + (size_t)(row0 + ai * 128 + m * 16) * D + col0;
#pragma unroll
                for (int bj = 0; bj < 2; ++bj) { const f32x4 v0 = acc[ai][bj][m][0] + *(const f32x4*)(yr + bj * 128), v1 = acc[ai][bj][m][1] + *(const f32x4*)(yr + bj * 128 + 4);
                    *(f32x4*)(yr + bj * 128) = v0; *(f32x4*)(yr + bj * 128 + 4) = v1; }
            }
    }
};
struct EpiFfn {
    static constexpr bool PERM = true;
    bf16_t* ACT; const float* rss2; const float* cw; const float* cb; const float* stf; float* edge; float* outp; float* outs; LAS unsigned char* lx;
    template <bool SAMPLE>
    __device__ __forceinline__ void body(f32x4 (&acc)[2][2][4][2], const Unit& u, int, int, int, int) const {
        LAS float* RS = (LAS float*)lx; LAS float* XCH = RS + 256;
        int tid = threadIdx.x; asm volatile("" : "+v"(tid));
        const int wid = __builtin_amdgcn_readfirstlane(tid >> 6), wr = wid >> 2, wc = wid & 3, fr = tid & 15, fq = (tid >> 4) & 3;
        { const int row = tid >> 1, half = tid & 1; const f32x4* p = (const f32x4*)(rss2 + (size_t)(u.pm * 256 + row) * 16 + half * 8);
          const f32x4 a = p[0], b = p[1]; float s = ((a[0] + a[1]) + (a[2] + a[3])) + ((b[0] + b[1]) + (b[2] + b[3]));
          s += __shfl_xor(s, 1);
          if (!half) RS[row] = rsqrtf(s * (1.0f / D) + EPS); }
        asm volatile("s_waitcnt lgkmcnt(0)" ::: "memory"); __builtin_amdgcn_s_barrier(); asm volatile("" ::: "memory");
        const int cw0 = wc * 32 + 8 * fq;
        const LAS float* rsw = RS + wr * 64 + fr;
        if (!SAMPLE) {
            if (fr >= 14) {
#pragma unroll
                for (int ai = 0; ai < 2; ++ai) { const int seg = 2 * ai + wr; const float s = rsw[ai * 128 + 48];
                    if (seg < 3) {
#pragma unroll
                        for (int bj = 0; bj < 2; ++bj)
#pragma unroll
                            for (int n = 0; n < 2; ++n) *(LAS f32x4*)(XCH + (seg * 2 + (fr - 14)) * 256 + bj * 128 + cw0 + 4 * n) = acc[ai][bj][3][n] * s; } }
            }
            if (wr == 0 && fr < 2) { float* e = edge + ((size_t)u.pm * 4 + fr) * FF2 + u.pn * 128 + cw0; const float s = rsw[0];
#pragma unroll
                for (int bj = 0; bj < 2; ++bj)
#pragma unroll
                    for (int n = 0; n < 2; ++n) *(f32x4*)(e + bj * FF + 4 * n) = acc[0][bj][0][n] * s; }
            if (wr == 1 && fr >= 14) { float* e = edge + ((size_t)u.pm * 4 + 2 + (fr - 14)) * FF2 + u.pn * 128 + cw0; const float s = rsw[128 + 48];
#pragma unroll
                for (int bj = 0; bj < 2; ++bj)
#pragma unroll
                    for (int n = 0; n < 2; ++n) *(f32x4*)(e + bj * FF + 4 * n) = acc[1][bj][3][n] * s;
                if ((u.pm & 7) == 7) { float* o = outp + ((size_t)(u.pm >> 3) * 2 + (fr - 14)) * FF2 + u.pn * 128 + cw0;
#pragma unroll
                    for (int bj = 0; bj < 2; ++bj)
#pragma unroll
                        for (int n = 0; n < 2; ++n) *(f32x4*)(o + bj * FF + 4 * n) = acc[1][bj][3][n] * s; } }
        } else {
            if ((fr & 7) >= 6) {
#pragma unroll
                for (int ai = 0; ai < 2; ++ai)
#pragma unroll
                    for (int m = 0; m < 4; ++m) { const int b = ((u.pm - 64) * 256 + ai * 128 + wr * 64 + m * 16 + fr) >> 3; const float s = rsw[ai * 128 + m * 16];
                        float* o = outs + ((size_t)b * 2 + ((fr & 7) - 6)) * FF2 + u.pn * 128 + cw0;
#pragma unroll
                        for (int bj = 0; bj < 2; ++bj)
#pragma unroll
                            for (int n = 0; n < 2; ++n) *(f32x4*)(o + bj * FF + 4 * n) = acc[ai][bj][m][n] * s; }
            }
        }
        asm volatile("s_waitcnt lgkmcnt(0)" ::: "memory"); __builtin_amdgcn_s_barrier(); asm volatile("" ::: "memory");
        unsigned keep[2][2][2][4];
#pragma unroll
        for (int n = 0; n < 2; ++n)
#pragma unroll
        for (int jp = 0; jp < 2; ++jp) {
            __builtin_amdgcn_sched_barrier(0);
            const int c0 = cw0 + 4 * n + 2 * jp, gcol = u.pn * 128 + c0, vcol = FF + gcol;
            const f32x2 wg0 = *(const f32x2*)(cw + gcol), wg1 = *(const f32x2*)(cw + FF2 + gcol), wg2 = *(const f32x2*)(cw + 2 * FF2 + gcol), bg = *(const f32x2*)(cb + gcol);
            const f32x2 wv0 = *(const f32x2*)(cw + vcol), wv1 = *(const f32x2*)(cw + FF2 + vcol), wv2 = *(const f32x2*)(cw + 2 * FF2 + vcol), bv = *(const f32x2*)(cb + vcol);
            f32x2 p1g, p2g, p1v, p2v;
#pragma unroll
            for (int ai = 0; ai < 2; ++ai) {
                if (!SAMPLE) {
                    const int seg = 2 * ai + wr;
                    if (seg == 0) { p1g = p2g = p1v = p2v = (f32x2){0.f, 0.f}; }
                    else { const LAS float* xb = XCH + (seg - 1) * 512 + c0;
                        p1g = *(const LAS f32x2*)(xb + 256); p2g = *(const LAS f32x2*)(xb + (fr & 1) * 256);
                        p1v = *(const LAS f32x2*)(xb + 256 + 128); p2v = *(const LAS f32x2*)(xb + (fr & 1) * 256 + 128); }
                }
#pragma unroll
                for (int m = 0; m < 4; ++m) {
                    const float s = rsw[ai * 128 + m * 16];
                    const f32x2 g = (f32x2){acc[ai][0][m][n][2 * jp], acc[ai][0][m][n][2 * jp + 1]} * s, v = (f32x2){acc[ai][1][m][n][2 * jp], acc[ai][1][m][n][2 * jp + 1]} * s;
                    f32x2 g1, g2, v1, v2;
                    if (!SAMPLE) {
#pragma unroll
                        for (int j = 0; j < 2; ++j) { g1[j] = dppf<DPP_SHR(1)>(p1g[j], g[j]); g2[j] = dppf<DPP_SHR(2)>(p2g[j], g[j]);
                            v1[j] = dppf<DPP_SHR(1)>(p1v[j], v[j]); v2[j] = dppf<DPP_SHR(2)>(p2v[j], v[j]); }
#pragma unroll
                        for (int j = 0; j < 2; ++j) { p1g[j] = dppf<DPP_ROR(1)>(0.f, g[j]); p2g[j] = dppf<DPP_ROR(2)>(0.f, g[j]);
                            p1v[j] = dppf<DPP_ROR(1)>(0.f, v[j]); p2v[j] = dppf<DPP_ROR(2)>(0.f, v[j]); }
                    } else {
                        const int b = ((u.pm - 64) * 256 + ai * 128 + wr * 64 + m * 16 + fr) >> 3, sq = fr & 7;
#pragma unroll
                        for (int j = 0; j < 2; ++j) { g1[j] = dppf<DPP_SHR(1)>(0.f, g[j]); g2[j] = dppf<DPP_SHR(2)>(0.f, g[j]);
                            v1[j] = dppf<DPP_SHR(1)>(0.f, v[j]); v2[j] = dppf<DPP_SHR(2)>(0.f, v[j]); }
                        if (sq < 2) { const float* sp = stf + ((size_t)b * 2 + sq) * FF2; g2 = *(const f32x2*)(sp + gcol); v2 = *(const f32x2*)(sp + vcol);
                            if (sq == 0) { g1 = *(const f32x2*)(sp + FF2 + gcol); v1 = *(const f32x2*)(sp + FF2 + vcol); } }
                    }
                    const f32x2 ug = bg + wg0 * g2 + wg1 * g1 + wg2 * g, uv = bv + wv0 * v2 + wv1 * v1 + wv2 * v;
                    keep[n][jp][ai][m] = cvt_pk_bf16(gelu_tanh(ug[0]) * uv[0], gelu_tanh(ug[1]) * uv[1]);
                }
            }
        }
        __builtin_amdgcn_sched_barrier(0);
#pragma unroll
        for (int ai = 0; ai < 2; ++ai)
#pragma unroll
            for (int m = 0; m < 4; ++m)
                *(u32x4*)(ACT + (size_t)(u.pm * 256 + ai * 128 + wr * 64 + m * 16 + fr) * FF + u.pn * 128 + cw0) = (u32x4){keep[0][0][ai][m], keep[0][1][ai][m], keep[1][0][ai][m], keep[1][1][ai][m]};
    }
    __device__ __forceinline__ void operator()(f32x4 (&acc)[2][2][4][2], const Unit& u, int wr, int wc, int fr, int fq) const {
        if (u.pm >= 64) body<true>(acc, u, wr, wc, fr, fq); else body<false>(acc, u, wr, wc, fr, fq);
    }
};

struct Args { const float* in[24]; float* out; unsigned char* ws; int ph_lo, ph_hi; };
enum { I_XP = 0, I_XS, I_SLC, I_SH, I_SPOOL, I_SFFN, I_G1, I_WIN, I_LCW, I_LCB, I_WA, I_BA, I_WX, I_BX, I_LAM, I_PW, I_PSC, I_WOUT, I_G2, I_UP, I_FCW, I_FCB, I_DOWN, I_GF };

__device__ __forceinline__ void p0_transpose_item(const float* W, int K, int N, bf16_t* WT, const float* kscale, bool up_map, LAS float* scr, int item, int lane) {
    const int nblk = N / 32, kb = item / nblk, nb = item % nblk, k0 = 64 * kb, n0 = 32 * nb;
    int drow0 = n0;
    if (up_map) { const int bj = n0 / FF, f = n0 % FF; drow0 = 256 * (f >> 7) + 128 * bj + (f & 127); }
#pragma unroll 8
    for (int i = 0; i < 32; ++i) { const int kk = 2 * i + (lane >> 5); float v = W[(size_t)(k0 + kk) * N + n0 + (lane & 31)]; if (kscale) v *= kscale[k0 + kk]; scr[kk * 33 + (lane & 31)] = v; }
    asm volatile("s_waitcnt lgkmcnt(0)" ::: "memory");
    const int c = lane & 7;
#pragma unroll
    for (int j = 0; j < 4; ++j) { const int n = (lane >> 3) + 8 * j; const LAS float* s = scr + (8 * c) * 33 + n;
        u32x4 o; o.x = cvt_pk_bf16(s[0 * 33], s[1 * 33]); o.y = cvt_pk_bf16(s[2 * 33], s[3 * 33]); o.z = cvt_pk_bf16(s[4 * 33], s[5 * 33]); o.w = cvt_pk_bf16(s[6 * 33], s[7 * 33]);
        *(u32x4*)(WT + (size_t)(drow0 + n) * K + k0 + 8 * c) = o; }
    asm volatile("s_waitcnt lgkmcnt(0)" ::: "memory");
}

struct MixCtx { const bf16_t* Z; float* HL; float* PP; bf16_t* MIX; const float* pscale; };

__device__ __forceinline__ void blk_desc(int blk, int& zrow0, bool& hasprev, int& segmask) {
    if (blk < 1024) { zrow0 = blk * 16; hasprev = (blk & 127) != 0; segmask = 15; }
    else { zrow0 = MP + (blk - 1024) * 32 + 16; hasprev = true; segmask = 7; }
}

__device__ __forceinline__ void lru_item(const MixCtx& C, int h, int blk, const bf16x8 (&WA)[4][2], const bf16x8 (&WX)[4][2], const LAS float* KC, int lane) {
    const int r = lane & 15, q = lane >> 4;
    int zrow0, segmask; bool hasprev; blk_desc(blk, zrow0, hasprev, segmask);
    const bf16_t* zp = C.Z + (size_t)(zrow0 + r) * DIN + h * 64 + q * 8;
    u32x4 zc[2], zq[2];
    zc[0] = *(const u32x4*)zp; zc[1] = *(const u32x4*)(zp + 32);
    zq[0] = zq[1] = (u32x4){0u, 0u, 0u, 0u};
    if (hasprev) { zq[0] = *(const u32x4*)(zp - 16 * DIN); zq[1] = *(const u32x4*)(zp - 16 * DIN + 32); }
    float xc[2][8]; bf16x8 Bf[2];
#pragma unroll
    for (int kb = 0; kb < 2; ++kb) {
        const LAS float* kc = KC + kb * 32 + q * 8;
        f32x4 w[4][2], bb[2];
#pragma unroll
        for (int t = 0; t < 4; ++t) { w[t][0] = *(const LAS f32x4*)(kc + t * 64); w[t][1] = *(const LAS f32x4*)(kc + t * 64 + 4); }
        bb[0] = *(const LAS f32x4*)(kc + 256); bb[1] = *(const LAS f32x4*)(kc + 260);
#pragma unroll
        for (int i2 = 0; i2 < 4; ++i2) {
            const unsigned c0 = zc[kb][i2], pv = zq[kb][i2];
            const unsigned s1 = shiftu<1>(pv, c0), s2 = shiftu<2>(pv, c0), s3 = shiftu<3>(pv, c0);
            const int e = 2 * i2, hh = e >> 2, ee = e & 3;
            xc[kb][e]     = bb[hh][ee]     + w[3][hh][ee]     * bf_lo(c0) + w[2][hh][ee]     * bf_lo(s1) + w[1][hh][ee]     * bf_lo(s2) + w[0][hh][ee]     * bf_lo(s3);
            xc[kb][e + 1] = bb[hh][ee + 1] + w[3][hh][ee + 1] * bf_hi(c0) + w[2][hh][ee + 1] * bf_hi(s1) + w[1][hh][ee + 1] * bf_hi(s2) + w[0][hh][ee + 1] * bf_hi(s3);
        }
        u32x4 pk; pk.x = cvt_pk_bf16(xc[kb][0], xc[kb][1]); pk.y = cvt_pk_bf16(xc[kb][2], xc[kb][3]); pk.z = cvt_pk_bf16(xc[kb][4], xc[kb][5]); pk.w = cvt_pk_bf16(xc[kb][6], xc[kb][7]);
        Bf[kb] = __builtin_bit_cast(bf16x8, pk);
    }
    const bool m1 = (r & segmask) < 1, m2 = (r & segmask) < 2, m4 = (r & segmask) < 4, m8 = (r & segmask) < 8;
#pragma unroll
    for (int n = 0; n < 4; ++n) {
        const int kb = n >> 1, half = n & 1;
        f32x4 R = {0.f, 0.f, 0.f, 0.f}, I = {0.f, 0.f, 0.f, 0.f};
        R = __builtin_amdgcn_mfma_f32_16x16x32_bf16(WA[n][0], Bf[0], R, 0, 0, 0); R = __builtin_amdgcn_mfma_f32_16x16x32_bf16(WA[n][1], Bf[1], R, 0, 0, 0);
        I = __builtin_amdgcn_mfma_f32_16x16x32_bf16(WX[n][0], Bf[0], I, 0, 0, 0); I = __builtin_amdgcn_mfma_f32_16x16x32_bf16(WX[n][1], Bf[1], I, 0, 0, 0);
        const LAS float* kc = KC + kb * 32 + q * 8 + half * 4;
        const f32x4 ba = *(const LAS f32x4*)(kc + 320), bx = *(const LAS f32x4*)(kc + 384), sp = *(const LAS f32x4*)(kc + 448);
        f32x4 a, b;
#pragma unroll
        for (int j = 0; j < 4; ++j) {
            const float rg = sigmoidf_(R[j] + ba[j]), ig = sigmoidf_(I[j] + bx[j]);
            const float la = -8.0f * rg * sp[j];
            a[j] = __builtin_amdgcn_exp2f(1.4426950409f * la);
            const float x2 = 2.0f * la;
            const float mm = x2 > -0.125f ? -x2 * (1.0f + x2 * (0.5f + x2 * (0.16666667f + x2 * (0.041666667f + x2 * 0.0083333333f)))) : 1.0f - a[j] * a[j];
            b[j] = sqrtf(mm) * ig * xc[kb][half * 4 + j];
        }
#define SCAN_STEP(Dd, MSK) _Pragma("unroll") for (int j = 0; j < 4; ++j) { float ap = dppf<DPP_SHR(Dd)>(1.0f, a[j]), bp = dppf<DPP_SHR(Dd)>(0.0f, b[j]); \
            if (MSK) { ap = 1.0f; bp = 0.0f; } b[j] = a[j] * bp + b[j]; a[j] = a[j] * ap; }
        SCAN_STEP(1, m1) SCAN_STEP(2, m2) SCAN_STEP(4, m4) SCAN_STEP(8, m8)
#undef SCAN_STEP
        const size_t o = (size_t)(zrow0 + r) * DL + h * 64 + kb * 32 + q * 8 + half * 4;
        *(f32x4*)(C.PP + o) = a; *(f32x4*)(C.HL + o) = b;
    }
}

__device__ __forceinline__ void pool_item(const MixCtx& C, int g, int blk, const LAS unsigned char* PWL, int lane) {
    const int r = lane & 15, q = lane >> 4;
    int zrow0, segmask; bool hasprev; blk_desc(blk, zrow0, hasprev, segmask);
    const bool prompt = blk < 1024;
    const int orow = prompt ? zrow0 + r : MP + (blk - 1024) * 8 + (r - 8);
    const bool valid = prompt || r >= 8;
    const int w = 2 << g;
    int cnt = w; if (prompt) { const int t1 = ((zrow0 + r) & 2047) + 1; cnt = t1 < w ? t1 : w; }
    const float inv = 1.0f / (float)cnt;
    const bf16_t* zp = C.Z + (size_t)(zrow0 + r) * DIN + 1024 + g * 128 + q * 8;
    bf16x8 Bf[4];
#pragma unroll
    for (int ks = 0; ks < 4; ++ks) {
        const u32x4 c = *(const u32x4*)(zp + ks * 32);
        u32x4 p = {0u, 0u, 0u, 0u}; if (hasprev) p = *(const u32x4*)(zp + ks * 32 - 16 * DIN);
        float pl[8];
#pragma unroll
        for (int e = 0; e < 8; ++e) {
            const float x = (e & 1) ? bf_hi(c[e >> 1]) : bf_lo(c[e >> 1]);
            float PS = (e & 1) ? bf_hi(p[e >> 1]) : bf_lo(p[e >> 1]);
            float S = x;
            S += shiftf<1>(PS, S);
            if (g >= 1) { PS += dppf<DPP_SHR(1)>(0.f, PS); S += shiftf<2>(PS, S); }
            if (g >= 2) { PS += dppf<DPP_SHR(2)>(0.f, PS); S += shiftf<4>(PS, S); }
            if (g >= 3) { PS += dppf<DPP_SHR(4)>(0.f, PS); S += shiftf<8>(PS, S); }
            pl[e] = S * inv - x;
        }
        u32x4 pk; pk.x = cvt_pk_bf16(pl[0], pl[1]); pk.y = cvt_pk_bf16(pl[2], pl[3]); pk.z = cvt_pk_bf16(pl[4], pl[5]); pk.w = cvt_pk_bf16(pl[6], pl[7]);
        Bf[ks] = __builtin_bit_cast(bf16x8, pk);
    }
#pragma unroll
    for (int m2 = 0; m2 < 4; ++m2) {
        f32x4 y[2];
#pragma unroll
        for (int half = 0; half < 2; ++half) {
            const int out = m2 * 32 + (r >> 2) * 8 + half * 4 + (r & 3);
            const LAS unsigned char* wrow = PWL + (g * 128 + out) * 256;
            f32x4 Dv = {0.f, 0.f, 0.f, 0.f};
#pragma unroll
            for (int ks = 0; ks < 4; ++ks) { const bf16x8 A = *(const LAS bf16x8*)(wrow + (((ks * 4 + q) ^ r) << 4)); Dv = __builtin_amdgcn_mfma_f32_16x16x32_bf16(A, Bf[ks], Dv, 0, 0, 0); }
            const f32x4 sc = *(const f32x4*)(C.pscale + g * 128 + m2 * 32 + q * 8 + half * 4);
            y[half] = Dv * sc;
        }
        if (valid) { u32x4 pk; pk.x = cvt_pk_bf16(y[0][0], y[0][1]); pk.y = cvt_pk_bf16(y[0][2], y[0][3]); pk.z = cvt_pk_bf16(y[1][0], y[1][1]); pk.w = cvt_pk_bf16(y[1][2], y[1][3]);
            *(u32x4*)(C.MIX + (size_t)orow * D + 512 + g * 128 + m2 * 32 + q * 8) = pk; }
    }
}

__global__ void __launch_bounds__(512, 2) fwd_kernel(Args args) {
    extern __shared__ __attribute__((aligned(16))) unsigned char lds_raw[];
    LAS unsigned char* lds = (LAS unsigned char*)lds_raw;
    cg::grid_group grid = cg::this_grid();
    const int G = gridDim.x, NGW = G * 8, NGT = G * 512;
#define TID_SETUP int tid = threadIdx.x; asm volatile("" : "+v"(tid)); const int lane = tid & 63, wave = __builtin_amdgcn_readfirstlane(tid >> 6), gw = blockIdx.x * 8 + wave, gt = blockIdx.x * 512 + tid; (void)lane; (void)gw; (void)gt;
    unsigned char* ws = args.ws; float* out = args.out;
    bf16_t* Wi_t = (bf16_t*)(ws + WS_WI); bf16_t* Wo_t = (bf16_t*)(ws + WS_WO); bf16_t* Wu_t = (bf16_t*)(ws + WS_WU); bf16_t* Wd_t = (bf16_t*)(ws + WS_WD);
    bf16_t* WA_t = (bf16_t*)(ws + WS_WA); bf16_t* WX_t = (bf16_t*)(ws + WS_WX); bf16_t* PW_t = (bf16_t*)(ws + WS_PW);
    float* rs1 = (float*)(ws + WS_RS1); float* rss2 = (float*)(ws + WS_RSS2); float* edge = (float*)(ws + WS_EDGE);
    bf16_t* XB = (bf16_t*)(ws + WS_XB); bf16_t* MIX = (bf16_t*)(ws + WS_MIX); bf16_t* Z = (bf16_t*)(ws + WS_Z);
    float* HL = (float*)(ws + WS_HL); float* PP = (float*)(ws + WS_PP); bf16_t* ACT = (bf16_t*)(ws + WS_ACT);
    const int lo = args.ph_lo, hi = args.ph_hi;
#define IN(k) (lo <= (k) && (k) < hi)
#define SEAM(k) do { if (IN(k) && IN((k) + 1)) grid.sync(); } while (0)

    if (IN(0)) {
        TID_SETUP
        LAS float* scr = (LAS float*)(lds + wave * 16384);
        constexpr int I_WI = 16 * 48, I_WO = 16 * 32, I_WU = 16 * 192, I_WD = 48 * 32, I_G = 8 * 2, I_P = 4 * 8;
        constexpr int NIT = I_WI + I_WO + I_WU + I_WD + 2 * I_G + I_P;
        for (int it = gw; it < NIT; it += NGW) {
            int r = it;
            if (r < I_WU) { p0_transpose_item(args.in[I_UP], D, FF2, Wu_t, args.in[I_G2], true, scr, r, lane); continue; } r -= I_WU;
            if (r < I_WD) { p0_transpose_item(args.in[I_DOWN], FF, D, Wd_t, nullptr, false, scr, r, lane); continue; } r -= I_WD;
            if (r < I_WI) { p0_transpose_item(args.in[I_WIN], D, DIN, Wi_t, args.in[I_G1], false, scr, r, lane); continue; } r -= I_WI;
            if (r < I_WO) { p0_transpose_item(args.in[I_WOUT], D, D, Wo_t, nullptr, false, scr, r, lane); continue; } r -= I_WO;
            if (r < I_G) { p0_transpose_item(args.in[I_WA] + (r >> 1) * 4096, 64, 64, WA_t + (r >> 1) * 4096, nullptr, false, scr, r & 1, lane); continue; } r -= I_G;
            if (r < I_G) { p0_transpose_item(args.in[I_WX] + (r >> 1) * 4096, 64, 64, WX_t + (r >> 1) * 4096, nullptr, false, scr, r & 1, lane); continue; } r -= I_G;
            p0_transpose_item(args.in[I_PW] + (r >> 3) * 16384, 128, 128, PW_t + (r >> 3) * 16384, nullptr, false, scr, r & 7, lane);
        }
        for (int m = gw; m < M; m += NGW) {
            const float* xrow = m < MP ? args.in[I_XP] + (size_t)m * D : args.in[I_XS] + (size_t)(m - MP) * D;
            const f32x4* xr = (const f32x4*)xrow + lane; f32x4 v[4]; float s = 0.f;
#pragma unroll
            for (int j = 0; j < 4; ++j) { v[j] = xr[64 * j]; s += (v[j][0] * v[j][0] + v[j][1] * v[j][1]) + (v[j][2] * v[j][2] + v[j][3] * v[j][3]); }
            s = wave_sum(s);
            if (lane == 0) rs1[m] = rsqrtf(s * (1.0f / D) + EPS);
            u32x2* o8 = (u32x2*)(XB + (size_t)m * D) + lane;
#pragma unroll
            for (int j = 0; j < 4; ++j) { u32x2 w; w.x = cvt_pk_bf16(v[j][0], v[j][1]); w.y = cvt_pk_bf16(v[j][2], v[j][3]); o8[64 * j] = w; }
        }
        for (int it = gw; it < 128 * 24; it += NGW) {
            const int b = it / 24, r = it % 24;
            bf16_t* zr = Z + (size_t)(MP + b * 32 + r) * DIN;
#pragma unroll
            for (int j = 0; j < 3; ++j) {
                const int c = lane * 8 + 512 * j; u32x4 w = {0u, 0u, 0u, 0u};
                const float* src = nullptr;
                if (j == 0 && r >= 21) src = args.in[I_SLC] + ((size_t)b * 3 + (r - 21)) * 512 + c;
                if (j == 2 && r >= 9) src = args.in[I_SPOOL] + ((size_t)b * 15 + (r - 9)) * 512 + (c - 1024);
                if (src) { const f32x4 a = *(const f32x4*)src, bq = *(const f32x4*)(src + 4); w.x = cvt_pk_bf16(a[0], a[1]); w.y = cvt_pk_bf16(a[2], a[3]); w.z = cvt_pk_bf16(bq[0], bq[1]); w.w = cvt_pk_bf16(bq[2], bq[3]); }
                *(u32x4*)(zr + c) = w;
            }
        }
        for (int i = gt; i < 128 * 7 * 512; i += NGT) { const int b = i / 3584, rem = i % 3584; out[O_SPOOL + (size_t)b * 7680 + rem] = args.in[I_SPOOL][(size_t)b * 7680 + 4096 + rem]; }
    }
    SEAM(0);

    if (IN(1)) {
        pg8::Gemm g{XB, Wi_t, M, DIN, D}; pg8::StaticOrder S; S.init(M, DIN, G, (int)blockIdx.x);
        EpiZ E{Z, rs1};
        pg8::gemm_phase<EpiZ, pg8::StaticOrder, true, true>(lds, g, S, E);
    }
    SEAM(1);

    if (IN(2)) {
        TID_SETUP
        for (int ch = tid; ch < 8192; ch += 512) { const int row = ch >> 4, c = ch & 15, o = row & 127, key = ((o >> 3) & 3) * 4 + (o & 3);
            *(LAS u32x4*)(lds + row * 256 + ((c ^ key) << 4)) = *(const u32x4*)(PW_t + (size_t)row * 128 + c * 8); }
        __syncthreads();
        MixCtx C{Z, HL, PP, MIX, args.in[I_PSC]};
        LAS float* KC = (LAS float*)(lds + LDS_X + wave * 2048);
        {
            const int i0 = (int)((long)gw * (8 * NBLK) / NGW), i1 = (int)((long)(gw + 1) * (8 * NBLK) / NGW);
            int curh = -1; bf16x8 WA[4][2], WX[4][2];
#pragma unroll
            for (int n = 0; n < 4; ++n)
#pragma unroll
                for (int k = 0; k < 2; ++k) { WA[n][k] = (bf16x8){0, 0, 0, 0, 0, 0, 0, 0}; WX[n][k] = WA[n][k]; }
            for (int it = i0; it < i1; ++it) {
                const int h = it / NBLK, blk = it % NBLK;
                if (h != curh) {
                    curh = h;
                    asm volatile("s_waitcnt lgkmcnt(0)" ::: "memory");
                    const int ch = h * 64 + lane;
#pragma unroll
                    for (int t = 0; t < 4; ++t) KC[t * 64 + lane] = args.in[I_LCW][t * 512 + ch];
                    KC[256 + lane] = args.in[I_LCB][ch]; KC[320 + lane] = args.in[I_BA][ch]; KC[384 + lane] = args.in[I_BX][ch];
                    { const float lam = args.in[I_LAM][ch]; KC[448 + lane] = log1pf(expf(-lam)); }
                    const int rho = lane & 15, qq = lane >> 4;
#pragma unroll
                    for (int n = 0; n < 4; ++n) { const int o = (n >> 1) * 32 + (rho >> 2) * 8 + (n & 1) * 4 + (rho & 3);
#pragma unroll
                        for (int k = 0; k < 2; ++k) { WA[n][k] = *(const bf16x8*)(WA_t + (size_t)(h * 64 + o) * 64 + k * 32 + qq * 8); WX[n][k] = *(const bf16x8*)(WX_t + (size_t)(h * 64 + o) * 64 + k * 32 + qq * 8); } }
                    asm volatile("s_waitcnt lgkmcnt(0)" ::: "memory");
                }
                lru_item(C, h, blk, WA, WX, KC, lane);
                asm volatile("" ::: "memory");
            }
        }
        {
            const int gwr = NGW - 1 - gw;
            const int i0 = (int)((long)gwr * (4 * NBLK) / NGW), i1 = (int)((long)(gwr + 1) * (4 * NBLK) / NGW);
            for (int it = i0; it < i1; ++it) { pool_item(C, it / NBLK, it % NBLK, lds, lane); asm volatile("" ::: "memory"); }
        }
        __syncthreads();
    }
    SEAM(2);

    if (IN(3)) {
        TID_SETUP
        for (int id = gw; id < 2048 + 1024; id += NGW) {
            if (id < 2048) {
                const int b = id >> 8, ck = (id & 255) >> 3, c = (id & 7) * 64 + lane; const size_t base = (size_t)b * 2048;
                float carry = 0.f;
                for (int k = 0; k < 4 * ck; ++k) { const size_t o = (base + 16 * k + 15) * DL + c; carry = PP[o] * carry + HL[o]; }
                float h = 0.f;
#pragma unroll 4
                for (int t = 0; t < 64; ++t) { const size_t row = base + 64 * ck + t; const size_t o = row * DL + c;
                    h = HL[o] + PP[o] * carry; if ((t & 15) == 15) carry = h;
                    const float zg = bf_one(Z[row * DIN + 512 + c]);
                    MIX[row * D + c] = (bf16_t)(cvt_pk_bf16(h * gelu_tanh(zg), 0.f) & 0xffffu); }
                if (ck == 31) out[O_PH + b * 512 + c] = h;
            } else {
                const int sid = id - 2048, b = sid >> 3, c = (sid & 7) * 64 + lane;
                const float carry = args.in[I_SH][b * 512 + c]; float h = 0.f;
#pragma unroll
                for (int s = 0; s < 8; ++s) { const size_t zr = (size_t)MP + b * 32 + 24 + s; const size_t o = zr * DL + c;
                    h = HL[o] + PP[o] * carry;
                    const float zg = bf_one(Z[zr * DIN + 512 + c]);
                    MIX[((size_t)MP + b * 8 + s) * D + c] = (bf16_t)(cvt_pk_bf16(h * gelu_tanh(zg), 0.f) & 0xffffu); }
                out[O_SH + b * 512 + c] = h;
            }
        }
        for (int i = gt; i < 8 * 3 * 512; i += NGT) { const int b = i / 1536, k = (i % 1536) >> 9, c = i & 511; out[O_PLC + i] = bf_one(Z[((size_t)b * 2048 + 2045 + k) * DIN + c]); }
        for (int i = gt; i < 8 * 15 * 512; i += NGT) { const int b = i / 7680, k = (i % 7680) >> 9, c = i & 511; out[O_PPOOL + i] = bf_one(Z[((size_t)b * 2048 + 2033 + k) * DIN + 1024 + c]); }
        for (int i = gt; i < 128 * 3 * 512; i += NGT) { const int b = i / 1536, k = (i % 1536) >> 9, c = i & 511; out[O_SLC + i] = bf_one(Z[((size_t)MP + b * 32 + 29 + k) * DIN + c]); }
        for (int i = gt; i < 128 * 8 * 512; i += NGT) { const int b = i >> 12, s = (i >> 9) & 7, c = i & 511; out[O_SPOOL + (size_t)b * 7680 + (7 + s) * 512 + c] = bf_one(Z[((size_t)MP + b * 32 + 24 + s) * DIN + 1024 + c]); }
    }
    SEAM(3);

    if (IN(4)) {
        pg8::Gemm g{MIX, Wo_t, M, D, D}; pg8::StaticOrder S; S.init(M, D, G, (int)blockIdx.x);
        EpiX1 E{args.in[I_XP], args.in[I_XS], out + O_Y, XB, rss2};
        pg8::gemm_phase<EpiX1, pg8::StaticOrder, true, true>(lds, g, S, E);
    }
    SEAM(4);

    if (IN(5)) {
        pg8::Gemm g{XB, Wu_t, M, FF2, D}; pg8::StaticOrder S; S.init(M, FF2, G, (int)blockIdx.x);
        EpiFfn E{ACT, rss2, args.in[I_FCW], args.in[I_FCB], args.in[I_SFFN], edge, out + O_PFFN, out + O_SFFN, lds + LDS_X};
        pg8::gemm_phase<EpiFfn, pg8::StaticOrder, true, true>(lds, g, S, E);
    }
    SEAM(5);

    if (IN(6)) {
        TID_SETUP
        const float* cw = args.in[I_FCW]; const float* cb = args.in[I_FCB];
        for (int i = gt; i < 64 * FF; i += NGT) {
            const int pm = i / FF, f = i % FF;
            if ((pm & 7) == 0) continue;
            const float* L = edge + ((size_t)(pm - 1) * 4 + 2) * FF2; const float* F = edge + (size_t)pm * 4 * FF2;
            float a0, a1;
            { const float l0 = L[f], l1 = L[FF2 + f], f0 = F[f], f1 = F[FF2 + f]; const float w0 = cw[f], w1 = cw[FF2 + f], w2 = cw[2 * FF2 + f], bb = cb[f];
              a0 = bb + w0 * l0 + w1 * l1 + w2 * f0; a1 = bb + w0 * l1 + w1 * f0 + w2 * f1; }
            float v0, v1;
            { const int fv = FF + f; const float l0 = L[fv], l1 = L[FF2 + fv], f0 = F[fv], f1 = F[FF2 + fv]; const float w0 = cw[fv], w1 = cw[FF2 + fv], w2 = cw[2 * FF2 + fv], bb = cb[fv];
              v0 = bb + w0 * l0 + w1 * l1 + w2 * f0; v1 = bb + w0 * l1 + w1 * f0 + w2 * f1; }
            ACT[(size_t)(pm * 256) * FF + f] = (bf16_t)(cvt_pk_bf16(gelu_tanh(a0) * v0, 0.f) & 0xffffu);
            ACT[(size_t)(pm * 256 + 1) * FF + f] = (bf16_t)(cvt_pk_bf16(gelu_tanh(a1) * v1, 0.f) & 0xffffu);
        }
    }
    SEAM(6);

    if (IN(7)) {
        pg8::Gemm g{ACT, Wd_t, M, D, FF}; pg8::StaticOrder S; S.init(M, D, G, (int)blockIdx.x);
        EpiX2 E{out + O_Y};
        pg8::gemm_phase<EpiX2, pg8::StaticOrder, true, true>(lds, g, S, E);
    }
    SEAM(7);

    if (IN(8)) {
        TID_SETUP
        f32x4 gf[4];
#pragma unroll
        for (int j = 0; j < 4; ++j) gf[j] = ((const f32x4*)args.in[I_GF])[lane + 64 * j];
        for (int m = gw; m < M; m += NGW) {
            f32x4* yr = (f32x4*)(out + O_Y + (size_t)m * D) + lane; f32x4 v[4]; float s = 0.f;
#pragma unroll
            for (int j = 0; j < 4; ++j) { v[j] = yr[64 * j]; s += (v[j][0] * v[j][0] + v[j][1] * v[j][1]) + (v[j][2] * v[j][2] + v[j][3] * v[j][3]); }
            s = wave_sum(s); const float rstd = rsqrtf(s * (1.0f / D) + EPS);
#pragma unroll
            for (int j = 0; j < 4; ++j) yr[64 * j] = v[j] * rstd * gf[j];
        }
    }
#undef IN
#undef SEAM
}

extern "C" void kernel_launch(void* const* d_in, const int* in_sizes, int n_in, void* d_out, int out_size, void* d_ws, size_t ws_size, hipStream_t stream) {
    static int grid = 0;
    if (grid == 0) {
        if (n_in != 24 || ws_size < WS_END) { fprintf(stderr, "kernel_launch: unexpected n_in %d / ws %zu\n", n_in, ws_size); grid = -1; return; }
        int dev = 0, cus = 0, per_cu = 0;
        if (hipGetDevice(&dev) != hipSuccess || hipDeviceGetAttribute(&cus, hipDeviceAttributeMultiprocessorCount, dev) != hipSuccess) { grid = -1; return; }
        if (hipFuncSetAttribute((const void*)fwd_kernel, hipFuncAttributeMaxDynamicSharedMemorySize, LDS_BYTES) != hipSuccess) { fprintf(stderr, "kernel_launch: hipFuncSetAttribute failed\n"); grid = -1; return; }
        if (hipOccupancyMaxActiveBlocksPerMultiprocessor(&per_cu, (const void*)fwd_kernel, 512, LDS_BYTES) != hipSuccess || per_cu < 1) { fprintf(stderr, "kernel_launch: occupancy query says %d\n", per_cu); (void)hipGetLastError(); per_cu = 1; }
        grid = cus * 1;
    }
    if (grid < 0) return;
    Args a{};
    for (int i = 0; i < 24; ++i) a.in[i] = (const float*)d_in[i];
    a.out = (float*)d_out; a.ws = (unsigned char*)d_ws;
#if MK_N_LAUNCHES == 1
    a.ph_lo = 0; a.ph_hi = 9;
    void* kargs[] = {&a};
    hipError_t e = hipLaunchCooperativeKernel((const void*)fwd_kernel, dim3(grid), dim3(512), kargs, LDS_BYTES, stream);
    if (e != hipSuccess) fprintf(stderr, "cooperative launch failed: %s (grid %d)\n", hipGetErrorString(e), grid);
#else
    for (int p = 0; p < 9; ++p) { a.ph_lo = p; a.ph_hi = p + 1; hipLaunchKernelGGL(fwd_kernel, dim3(grid), dim3(512), LDS_BYTES, stream, a); }
#endif
}
```

```cpp
#include <hip/hip_runtime.h>
#include <hip/hip_cooperative_groups.h>
#include <cstdio>
#include <cstdint>
namespace cg = cooperative_groups;

#ifndef REP_MASK
#define REP_MASK 0
#endif
#ifndef MK_N_LAUNCHES
#define MK_N_LAUNCHES 1
#endif

#define LAS __attribute__((address_space(3)))
typedef unsigned short bf16_t;
typedef short bf16x8 __attribute__((ext_vector_type(8)));
typedef float f32x4 __attribute__((ext_vector_type(4)));
typedef float f32x2 __attribute__((ext_vector_type(2)));
typedef unsigned u32x4 __attribute__((ext_vector_type(4)));
typedef unsigned u32x2 __attribute__((ext_vector_type(2)));

constexpr int MP = 16384, MS = 1024, M = MP + MS, D = 1024, DIN = 1536, DL = 512, FF = 3072, FF2 = 6144;
constexpr int ZROWS = MP + 128 * 32;
constexpr int NBLK = 1024 + 128;
constexpr float EPS = 1e-6f;

constexpr size_t O_Y = 0, O_PLC = 17825792, O_PH = 17838080, O_PPOOL = 17842176, O_PFFN = 17903616,
                 O_SLC = 18001920, O_SH = 18198528, O_SPOOL = 18264064, O_SFFN = 19247104;

constexpr size_t MiB = 1u << 20;
constexpr size_t WS_WI = 1 * MiB, WS_WO = 4 * MiB, WS_WU = 6 * MiB, WS_WD = 18 * MiB;
constexpr size_t WS_WA = 24 * MiB, WS_WX = WS_WA + 65536, WS_PW = WS_WX + 65536;
constexpr size_t WS_RS1 = 25 * MiB, WS_RSS2 = WS_RS1 + 131072;
constexpr size_t WS_EDGE = 27 * MiB;
constexpr size_t WS_XB = 34 * MiB;
constexpr size_t WS_MIX = 68 * MiB;
constexpr size_t WS_Z = 102 * MiB;
constexpr size_t WS_HL = 162 * MiB, WS_PP = 202 * MiB;
constexpr size_t WS_ACT = 102 * MiB;
constexpr size_t WS_END = 242 * MiB;

constexpr int LDS_BYTES = 147456 + 256;
constexpr int LDS_MISC = 147456;
constexpr int LDS_X = 131072;

__device__ __forceinline__ unsigned cvt_pk_bf16(float lo, float hi) { unsigned r; asm volatile("v_cvt_pk_bf16_f32 %0, %1, %2" : "=v"(r) : "v"(lo), "v"(hi)); return r; }
__device__ __forceinline__ float bf_lo(unsigned u) { return __builtin_bit_cast(float, u << 16); }
__device__ __forceinline__ float bf_hi(unsigned u) { return __builtin_bit_cast(float, u & 0xffff0000u); }
__device__ __forceinline__ float bf_one(bf16_t u) { return __builtin_bit_cast(float, (unsigned)u << 16); }
__device__ __forceinline__ float wave_sum(float v) {
#pragma unroll
    for (int o = 1; o < 64; o <<= 1) v += __shfl_xor(v, o);
    return v;
}
#define DPP_SHR(n) (0x110 + (n))
#define DPP_ROR(n) (0x120 + (n))
template <int CTRL> __device__ __forceinline__ unsigned dppu(unsigned old, unsigned src) { return (unsigned)__builtin_amdgcn_update_dpp((int)old, (int)src, CTRL, 0xf, 0xf, false); }
template <int CTRL> __device__ __forceinline__ float dppf(float old, float src) {
    return __builtin_bit_cast(float, __builtin_amdgcn_update_dpp(__builtin_bit_cast(int, old), __builtin_bit_cast(int, src), CTRL, 0xf, 0xf, false));
}
template <int Dd> __device__ __forceinline__ unsigned shiftu(unsigned prev, unsigned cur) { return dppu<DPP_SHR(Dd)>(dppu<DPP_ROR(Dd)>(0u, prev), cur); }
template <int Dd> __device__ __forceinline__ float shiftf(float prev, float cur) { return dppf<DPP_SHR(Dd)>(dppf<DPP_ROR(Dd)>(0.f, prev), cur); }

__device__ __forceinline__ float sigmoidf_(float x) { return __builtin_amdgcn_rcpf(1.0f + __builtin_amdgcn_exp2f(-1.4426950409f * x)); }
__device__ __forceinline__ float gelu_tanh(float x) {
    const float k = -2.302208198f;
    const float p = x * (k + (k * 0.044715f) * (x * x));
    return x * __builtin_amdgcn_rcpf(1.0f + __builtin_amdgcn_exp2f(p));
}

namespace pg8 {
constexpr int BM = 256, BK = 64, HALF = 128, HTB = HALF * BK * 2, STAGE_BYTES = 8 * HTB, NXCD = 8, WGM = 8;
__host__ __device__ __forceinline__ int lds_byte(int r, int c) { const int st = (r >> 4) * 2 + (c >> 5), rr = r & 15, cc = c & 31, ob = rr * 64 + cc * 2; return st * 1024 + (ob ^ (((ob >> 9) & 1) << 5)); }
__host__ __device__ __forceinline__ void stage_rc(int b, int& R, int& C) { const int st = b / 1024, sb = b % 1024, swz = sb ^ (((sb >> 9) & 1) << 5); R = (st >> 1) * 16 + swz / 64; C = (st & 1) * 32 + (swz % 64) / 2; }
__host__ __device__ __forceinline__ int perm32(int rho) { const int n = rho >> 4, i = rho & 15; return 8 * (i >> 2) + 4 * n + (i & 3); }

struct Unit { int pm, pn; };
struct Gemm { const bf16_t* A; const bf16_t* Bt; int M, N, K; };

struct StaticOrder {
    int nM, nN, nwg, G, c;
    __host__ __device__ void init(int M_, int N_, int G_, int c_) { nM = M_ / BM; nN = N_ / BM; nwg = nM * nN; G = G_; c = c_; }
    __host__ __device__ bool next(int i, Unit& u) const {
        const long L = (long)i * G + c; if (L >= nwg) return false;
        int wgid = (int)L; { const int q = nwg / NXCD, r = nwg % NXCD, xcd = wgid % NXCD, off = wgid / NXCD; wgid = (xcd < r ? xcd * (q + 1) : r * (q + 1) + (xcd - r) * q) + off; }
        const int nig = WGM * nN, gid = wgid / nig, fm = gid * WGM, gsz = (nM - fm) < WGM ? (nM - fm) : WGM;
        u.pm = fm + ((wgid % nig) % gsz); u.pn = (wgid % nig) / gsz; return true;
    }
    __device__ __forceinline__ void a_ready(const Unit&) const {}
    __device__ __forceinline__ void done(const Unit&) const {}
};

template <class Epi, class Sched, bool ALIGN_EPI = false, bool SP2 = false>
__device__ __forceinline__ void gemm_phase(LAS unsigned char* lds, const Gemm g, const Sched& S, const Epi& E) {
    const int tid = threadIdx.x, wid = __builtin_amdgcn_readfirstlane(tid >> 6), lane = tid & 63, wr = wid >> 2, wc = wid & 3, fr = lane & 15, fq = lane >> 4;
    const int K = g.K, nt = K / BK;
    unsigned voffA[2], voffB[2];
#pragma unroll
    for (int i = 0; i < 2; ++i) { int R, C; stage_rc(tid * 16 + i * 8192, R, C); const int Rb = Epi::PERM ? ((R & ~31) + perm32(R & 31)) : R;
        voffA[i] = (unsigned)(R * K + C) * 2u; voffB[i] = (unsigned)(Rb * K + C) * 2u; }
    const size_t kstep = (size_t)(BK * 2);
    const size_t hstep = (size_t)HALF * K * 2;
    const size_t tstep = 2 * hstep;
    const unsigned ldsw = (unsigned)wid * 1024u;
    const int aoff = lds_byte(wr * 64 + fr, fq * 8), boff = lds_byte(wc * 32 + fr, fq * 8);
#define PG8_SA(b, h) (((b) * 2 + (h)) * HTB)
#define PG8_SB(b, h) ((4 + (b) * 2 + (h)) * HTB)
#define PG8_STAGE(bufoff, gbase, voff) do { _Pragma("unroll") for (int _i = 0; _i < 2; ++_i) \
        __builtin_amdgcn_global_load_lds((const unsigned*)((const char*)(gbase) + (voff)[_i]), (LAS unsigned*)(lds + (bufoff) + ldsw + _i * 8192), 16, 0, 0); } while (0)
#define PG8_LDA(dst, b, h) do { _Pragma("unroll") for (int m = 0; m < 4; ++m) _Pragma("unroll") for (int k = 0; k < 2; ++k) dst[m][k] = *(const LAS bf16x8*)(lds + PG8_SA(b, h) + aoff + m * 2048 + k * 1024); } while (0)
#define PG8_LDB(dst, b, h) do { _Pragma("unroll") for (int n = 0; n < 2; ++n) _Pragma("unroll") for (int k = 0; k < 2; ++k) dst[n][k] = *(const LAS bf16x8*)(lds + PG8_SB(b, h) + boff + n * 2048 + k * 1024); } while (0)
#define PG8_MMA(ai, bj, At, Bt) do { __builtin_amdgcn_s_setprio(1); _Pragma("unroll") for (int m = 0; m < 4; ++m) _Pragma("unroll") for (int n = 0; n < 2; ++n) _Pragma("unroll") for (int k = 0; k < 2; ++k) \
        acc[ai][bj][m][n] = __builtin_amdgcn_mfma_f32_16x16x32_bf16(Bt[n][k], At[m][k], acc[ai][bj][m][n], 0, 0, 0); __builtin_amdgcn_s_setprio(0); } while (0)
#define PG8_WAIT_V(n) asm volatile("s_waitcnt vmcnt(" #n ")" ::: "memory")
#define PG8_WAIT_L(n) asm volatile("s_waitcnt lgkmcnt(" #n ")" ::: "memory")
#define PG8_BAR __builtin_amdgcn_s_barrier()
#define PG8_SCHED __builtin_amdgcn_sched_barrier(0)
    Unit cur, nxt; int ui = 0;
    if (!S.next(0, cur)) return;
    f32x4 acc[2][2][4][2];
#pragma unroll
    for (int a = 0; a < 2; ++a)
#pragma unroll
        for (int b = 0; b < 2; ++b)
#pragma unroll
            for (int m = 0; m < 4; ++m)
#pragma unroll
                for (int n = 0; n < 2; ++n) acc[a][b][m][n] = (f32x4){0.f, 0.f, 0.f, 0.f};
    bf16x8 At[4][2], B0[2][2], B1[2][2];
    const char* cA = (const char*)g.A + (size_t)cur.pm * tstep; const char* cB = (const char*)g.Bt + (size_t)cur.pn * tstep;
    S.a_ready(cur);
    if constexpr (SP2) {
        PG8_STAGE(PG8_SB(0, 0), cB, voffB); PG8_STAGE(PG8_SB(0, 1), cB + hstep, voffB); PG8_STAGE(PG8_SA(0, 0), cA, voffA); PG8_STAGE(PG8_SA(0, 1), cA + hstep, voffA);
        if (wr == 1) PG8_BAR;
        PG8_WAIT_V(2); PG8_BAR;
        PG8_STAGE(PG8_SB(1, 0), cB + kstep, voffB); PG8_STAGE(PG8_SA(1, 0), cA + kstep, voffA); PG8_STAGE(PG8_SB(1, 1), cB + hstep + kstep, voffB);
        PG8_WAIT_V(6); PG8_BAR;
    } else {
        PG8_STAGE(PG8_SB(0, 0), cB, voffB); PG8_STAGE(PG8_SA(0, 0), cA, voffA); PG8_STAGE(PG8_SB(0, 1), cB + hstep, voffB); PG8_STAGE(PG8_SA(0, 1), cA + hstep, voffA);
        if (wr == 1) PG8_BAR;
        PG8_WAIT_V(4); PG8_BAR;
        PG8_STAGE(PG8_SB(1, 0), cB + kstep, voffB); PG8_STAGE(PG8_SA(1, 0), cA + kstep, voffA); PG8_STAGE(PG8_SB(1, 1), cB + hstep + kstep, voffB);
        PG8_WAIT_V(6); PG8_BAR;
    }
    for (;;) {
        const bool has_next = S.next(ui + 1, nxt);
        const char* nA = has_next ? (const char*)g.A + (size_t)nxt.pm * tstep : cA; const char* nB = has_next ? (const char*)g.Bt + (size_t)nxt.pn * tstep : cB;
        for (int t = 0; t < nt; t += 2) {
            const bool last = (t == nt - 2);
            const char* a1 = cA + (size_t)(t + 1) * kstep;
            const char* a2 = last ? nA : cA + (size_t)(t + 2) * kstep; const char* b2 = last ? nB : cB + (size_t)(t + 2) * kstep;
            const char* a3 = a2 + kstep; const char* b3 = b2 + kstep;
            if (last && has_next) S.a_ready(nxt);
            if constexpr (SP2) {
            PG8_LDB(B0, 0, 0); PG8_LDB(B1, 0, 1); PG8_SCHED; PG8_LDA(At, 0, 0); PG8_STAGE(PG8_SA(1, 1), a1 + hstep, voffA);
            PG8_WAIT_V(8); PG8_WAIT_L(0); PG8_BAR; PG8_MMA(0, 0, At, B0); PG8_MMA(0, 1, At, B1); PG8_BAR; PG8_SCHED;
            PG8_LDA(At, 0, 1); PG8_STAGE(PG8_SB(0, 0), b2, voffB); PG8_STAGE(PG8_SB(0, 1), b2 + hstep, voffB); PG8_STAGE(PG8_SA(0, 0), a2, voffA);
            PG8_WAIT_V(8); PG8_WAIT_L(0); PG8_BAR; PG8_MMA(1, 0, At, B0); PG8_MMA(1, 1, At, B1); PG8_BAR; PG8_SCHED;
            PG8_LDB(B0, 1, 0); PG8_LDB(B1, 1, 1); PG8_SCHED; PG8_LDA(At, 1, 0); PG8_STAGE(PG8_SA(0, 1), a2 + hstep, voffA);
            PG8_WAIT_V(8); PG8_WAIT_L(0); PG8_BAR; PG8_MMA(0, 0, At, B0); PG8_MMA(0, 1, At, B1); PG8_BAR; PG8_SCHED;
            PG8_LDA(At, 1, 1); PG8_STAGE(PG8_SB(1, 0), b3, voffB); PG8_STAGE(PG8_SB(1, 1), b3 + hstep, voffB); PG8_STAGE(PG8_SA(1, 0), a3, voffA);
            PG8_WAIT_V(8); PG8_WAIT_L(0); PG8_BAR; PG8_MMA(1, 0, At, B0); PG8_MMA(1, 1, At, B1); PG8_BAR; PG8_SCHED;
            } else {
            PG8_LDB(B0, 0, 0); PG8_SCHED; PG8_LDA(At, 0, 0); PG8_STAGE(PG8_SA(1, 1), a1 + hstep, voffA);
            PG8_WAIT_L(8); PG8_BAR; PG8_WAIT_L(0); PG8_MMA(0, 0, At, B0); PG8_BAR; PG8_SCHED;
            PG8_LDB(B1, 0, 1); PG8_STAGE(PG8_SB(0, 0), b2, voffB);
            PG8_BAR; PG8_WAIT_L(0); PG8_MMA(0, 1, At, B1); PG8_BAR;
            PG8_LDA(At, 0, 1); PG8_STAGE(PG8_SA(0, 0), a2, voffA);
            PG8_BAR; PG8_WAIT_L(0); PG8_MMA(1, 0, At, B0); PG8_BAR; PG8_SCHED;
            PG8_STAGE(PG8_SB(0, 1), b2 + hstep, voffB);
            PG8_WAIT_V(6); PG8_BAR; PG8_MMA(1, 1, At, B1); PG8_BAR;
            PG8_LDB(B0, 1, 0); PG8_SCHED; PG8_LDA(At, 1, 0); PG8_STAGE(PG8_SA(0, 1), a2 + hstep, voffA);
            PG8_WAIT_L(8); PG8_BAR; PG8_WAIT_L(0); PG8_MMA(0, 0, At, B0); PG8_BAR; PG8_SCHED;
            PG8_LDB(B1, 1, 1); PG8_STAGE(PG8_SB(1, 0), b3, voffB);
            PG8_BAR; PG8_WAIT_L(0); PG8_MMA(0, 1, At, B1); PG8_BAR;
            PG8_LDA(At, 1, 1); PG8_STAGE(PG8_SA(1, 0), a3, voffA);
            PG8_BAR; PG8_WAIT_L(0); PG8_MMA(1, 0, At, B0); PG8_BAR; PG8_SCHED;
            PG8_STAGE(PG8_SB(1, 1), b3 + hstep, voffB);
            PG8_WAIT_V(6); PG8_BAR; PG8_MMA(1, 1, At, B1); PG8_BAR;
            }
        }
        if constexpr (ALIGN_EPI) { if (wr == 0) PG8_BAR; }
        E(acc, cur, wr, wc, fr, fq); S.done(cur);
        if (!has_next) break;
#pragma unroll
        for (int a = 0; a < 2; ++a)
#pragma unroll
            for (int b = 0; b < 2; ++b)
#pragma unroll
                for (int m = 0; m < 4; ++m)
#pragma unroll
                    for (int n = 0; n < 2; ++n) acc[a][b][m][n] = (f32x4){0.f, 0.f, 0.f, 0.f};
        cur = nxt; cA = nA; cB = nB; ++ui;
        if constexpr (ALIGN_EPI) { if (wr == 1) PG8_BAR; }
    }
    PG8_WAIT_V(0);
    if constexpr (!ALIGN_EPI) { if (wr == 0) PG8_BAR; }
    PG8_BAR;
#undef PG8_SA
#undef PG8_SB
#undef PG8_STAGE
#undef PG8_LDA
#undef PG8_LDB
#undef PG8_MMA
#undef PG8_WAIT_V
#undef PG8_WAIT_L
#undef PG8_BAR
#undef PG8_SCHED
}
}
using pg8::Unit;

struct EpiZ {
    static constexpr bool PERM = true;
    bf16_t* Z; const float* rs1;
    __device__ __forceinline__ void operator()(const f32x4 (&acc)[2][2][4][2], const Unit& u, int wr, int wc, int fr, int fq) const {
        const int row0 = u.pm * 256 + wr * 64 + fr, col0 = u.pn * 256 + wc * 32 + 8 * fq;
#pragma unroll
        for (int ai = 0; ai < 2; ++ai)
#pragma unroll
            for (int m = 0; m < 4; ++m) {
                const int row = row0 + ai * 128 + m * 16; const float s = rs1[row];
                const int orow = row < MP ? row : MP + ((row - MP) >> 3) * 32 + 24 + (row & 7);
                bf16_t* rowp = Z + (size_t)orow * DIN + col0;
#pragma unroll
                for (int bj = 0; bj < 2; ++bj) { const f32x4 v0 = acc[ai][bj][m][0] * s, v1 = acc[ai][bj][m][1] * s;
                    u32x4 w; w.x = cvt_pk_bf16(v0[0], v0[1]); w.y = cvt_pk_bf16(v0[2], v0[3]); w.z = cvt_pk_bf16(v1[0], v1[1]); w.w = cvt_pk_bf16(v1[2], v1[3]);
                    *(u32x4*)(rowp + bj * 128) = w; }
            }
    }
};
struct EpiX1 {
    static constexpr bool PERM = true;
    const float* xp; const float* xs; float* y; bf16_t* X1B; float* rss2;
    __device__ __forceinline__ void operator()(const f32x4 (&acc)[2][2][4][2], const Unit& u, int wr, int wc, int fr, int fq) const {
        const int row0 = u.pm * 256 + wr * 64 + fr, col0 = u.pn * 256 + wc * 32 + 8 * fq;
#pragma unroll
        for (int ai = 0; ai < 2; ++ai)
#pragma unroll
            for (int m = 0; m < 4; ++m) {
                const int row = row0 + ai * 128 + m * 16;
                const float* xr = (row < MP ? xp + (size_t)row * D : xs + (size_t)(row - MP) * D) + col0;
                float* yr = y + (size_t)row * D + col0; bf16_t* br = X1B + (size_t)row * D + col0; float ss = 0.f;
#pragma unroll
                for (int bj = 0; bj < 2; ++bj) { const f32x4 v0 = acc[ai][bj][m][0] + *(const f32x4*)(xr + bj * 128), v1 = acc[ai][bj][m][1] + *(const f32x4*)(xr + bj * 128 + 4);
                    *(f32x4*)(yr + bj * 128) = v0; *(f32x4*)(yr + bj * 128 + 4) = v1;
                    u32x4 w; w.x = cvt_pk_bf16(v0[0], v0[1]); w.y = cvt_pk_bf16(v0[2], v0[3]); w.z = cvt_pk_bf16(v1[0], v1[1]); w.w = cvt_pk_bf16(v1[2], v1[3]);
                    *(u32x4*)(br + bj * 128) = w;
                    ss += (v0[0] * v0[0] + v0[1] * v0[1]) + (v0[2] * v0[2] + v0[3] * v0[3]) + (v1[0] * v1[0] + v1[1] * v1[1]) + (v1[2] * v1[2] + v1[3] * v1[3]); }
                ss += __shfl_xor(ss, 16); ss += __shfl_xor(ss, 32);
                if (fq == 0) rss2[(size_t)row * 16 + u.pn * 4 + wc] = ss;
            }
    }
};
struct EpiX2 {
    static constexpr bool PERM = true;
    float* y;
    __device__ __forceinline__ void operator()(const f32x4 (&acc)[2][2][4][2], const Unit& u, int wr, int wc, int fr, int fq) const {
        const int row0 = u.pm * 256 + wr * 64 + fr, col0 = u.pn * 256 + wc * 32 + 8 * fq;
#pragma unroll
        for (int ai = 0; ai < 2; ++ai)
#pragma unroll
            for (int m = 0; m < 4; ++m) {
                float* yr = y + (size_t)(row0 + ai * 128 + m * 16) * D + col0;
#pragma unroll
                for (int bj = 0; bj < 2; ++bj) { const f32x4 v0 = acc[ai][bj][m][0] + *(const f32x4*)(yr + bj * 128), v1 = acc[ai][bj][m][1] + *(const f32x4*)(yr + bj * 128 + 4);
                    *(f32x4*)(yr + bj * 128) = v0; *(f32x4*)(yr + bj * 128 + 4) = v1; }
            }
    }
};
struct EpiFfn {
    static constexpr bool PERM = true;
    bf16_t* ACT; const float* rss2; const float* cw; const float* cb; const float* stf; float* edge; float* outp; float* outs; LAS unsigned char* lx;
    template <bool SAMPLE>
    __device__ __forceinline__ void body(f32x4 (&acc)[2][2][4][2], const Unit& u, int, int, int, int) const {
        LAS float* RS = (LAS float*)lx; LAS float* XCH = RS + 256;
        int tid = threadIdx.x; asm volatile("" : "+v"(tid));
        const int wid = __builtin_amdgcn_readfirstlane(tid >> 6), wr = wid >> 2, wc = wid & 3, fr = tid & 15, fq = (tid >> 4) & 3;
        { const int row = tid >> 1, half = tid & 1; const f32x4* p = (const f32x4*)(rss2 + (size_t)(u.pm * 256 + row) * 16 + half * 8);
          const f32x4 a = p[0], b = p[1]; float s = ((a[0] + a[1]) + (a[2] + a[3])) + ((b[0] + b[1]) + (b[2] + b[3]));
          s += __shfl_xor(s, 1);
          if (!half) RS[row] = rsqrtf(s * (1.0f / D) + EPS); }
        asm volatile("s_waitcnt lgkmcnt(0)" ::: "memory"); __builtin_amdgcn_s_barrier(); asm volatile("" ::: "memory");
        const int cw0 = wc * 32 + 8 * fq;
        const LAS float* rsw = RS + wr * 64 + fr;
        if (!SAMPLE) {
            if (fr >= 14) {
#pragma unroll
                for (int ai = 0; ai < 2; ++ai) { const int seg = 2 * ai + wr; const float s = rsw[ai * 128 + 48];
                    if (seg < 3) {
#pragma unroll
                        for (int bj = 0; bj < 2; ++bj)
#pragma unroll
                            for (int n = 0; n < 2; ++n) *(LAS f32x4*)(XCH + (seg * 2 + (fr - 14)) * 256 + bj * 128 + cw0 + 4 * n) = acc[ai][bj][3][n] * s; } }
            }
            if (wr == 0 && fr < 2) { float* e = edge + ((size_t)u.pm * 4 + fr) * FF2 + u.pn * 128 + cw0; const float s = rsw[0];
#pragma unroll
                for (int bj = 0; bj < 2; ++bj)
#pragma unroll
                    for (int n = 0; n < 2; ++n) *(f32x4*)(e + bj * FF + 4 * n) = acc[0][bj][0][n] * s; }
            if (wr == 1 && fr >= 14) { float* e = edge + ((size_t)u.pm * 4 + 2 + (fr - 14)) * FF2 + u.pn * 128 + cw0; const float s = rsw[128 + 48];
#pragma unroll
                for (int bj = 0; bj < 2; ++bj)
#pragma unroll
                    for (int n = 0; n < 2; ++n) *(f32x4*)(e + bj * FF + 4 * n) = acc[1][bj][3][n] * s;
                if ((u.pm & 7) == 7) { float* o = outp + ((size_t)(u.pm >> 3) * 2 + (fr - 14)) * FF2 + u.pn * 128 + cw0;
#pragma unroll
                    for (int bj = 0; bj < 2; ++bj)
#pragma unroll
                        for (int n = 0; n < 2; ++n) *(f32x4*)(o + bj * FF + 4 * n) = acc[1][bj][3][n] * s; } }
        } else {
            if ((fr & 7) >= 6) {
#pragma unroll
                for (int ai = 0; ai < 2; ++ai)
#pragma unroll
                    for (int m = 0; m < 4; ++m) { const int b = ((u.pm - 64) * 256 + ai * 128 + wr * 64 + m * 16 + fr) >> 3; const float s = rsw[ai * 128 + m * 16];
                        float* o = outs + ((size_t)b * 2 + ((fr & 7) - 6)) * FF2 + u.pn * 128 + cw0;
#pragma unroll
                        for (int bj = 0; bj < 2; ++bj)
#pragma unroll
                            for (int n = 0; n < 2; ++n) *(f32x4*)(o + bj * FF + 4 * n) = acc[ai][bj][m][n] * s; }
            }
        }
        asm volatile("s_waitcnt lgkmcnt(0)" ::: "memory"); __builtin_amdgcn_s_barrier(); asm volatile("" ::: "memory");
        unsigned keep[2][2][2][4];
#pragma unroll
        for (int n = 0; n < 2; ++n)
#pragma unroll
        for (int jp = 0; jp < 2; ++jp) {
            __builtin_amdgcn_sched_barrier(0);
            const int c0 = cw0 + 4 * n + 2 * jp, gcol = u.pn * 128 + c0, vcol = FF + gcol;
            const f32x2 wg0 = *(const f32x2*)(cw + gcol), wg1 = *(const f32x2*)(cw + FF2 + gcol), wg2 = *(const f32x2*)(cw + 2 * FF2 + gcol), bg = *(const f32x2*)(cb + gcol);
            const f32x2 wv0 = *(const f32x2*)(cw + vcol), wv1 = *(const f32x2*)(cw + FF2 + vcol), wv2 = *(const f32x2*)(cw + 2 * FF2 + vcol), bv = *(const f32x2*)(cb + vcol);
            f32x2 p1g, p2g, p1v, p2v;
#pragma unroll
            for (int ai = 0; ai < 2; ++ai) {
                if (!SAMPLE) {
                    const int seg = 2 * ai + wr;
                    if (seg == 0) { p1g = p2g = p1v = p2v = (f32x2){0.f, 0.f}; }
                    else { const LAS float* xb = XCH + (seg - 1) * 512 + c0;
                        p1g = *(const LAS f32x2*)(xb + 256); p2g = *(const LAS f32x2*)(xb + (fr & 1) * 256);
                        p1v = *(const LAS f32x2*)(xb + 256 + 128); p2v = *(const LAS f32x2*)(xb + (fr & 1) * 256 + 128); }
                }
#pragma unroll
                for (int m = 0; m < 4; ++m) {
                    const float s = rsw[ai * 128 + m * 16];
                    const f32x2 g = (f32x2){acc[ai][0][m][n][2 * jp], acc[ai][0][m][n][2 * jp + 1]} * s, v = (f32x2){acc[ai][1][m][n][2 * jp], acc[ai][1][m][n][2 * jp + 1]} * s;
                    f32x2 g1, g2, v1, v2;
                    if (!SAMPLE) {
#pragma unroll
                        for (int j = 0; j < 2; ++j) { g1[j] = dppf<DPP_SHR(1)>(p1g[j], g[j]); g2[j] = dppf<DPP_SHR(2)>(p2g[j], g[j]);
                            v1[j] = dppf<DPP_SHR(1)>(p1v[j], v[j]); v2[j] = dppf<DPP_SHR(2)>(p2v[j], v[j]); }
#pragma unroll
                        for (int j = 0; j < 2; ++j) { p1g[j] = dppf<DPP_ROR(1)>(0.f, g[j]); p2g[j] = dppf<DPP_ROR(2)>(0.f, g[j]);
                            p1v[j] = dppf<DPP_ROR(1)>(0.f, v[j]); p2v[j] = dppf<DPP_ROR(2)>(0.f, v[j]); }
                    } else {
                        const int b = ((u.pm - 64) * 256 + ai * 128 + wr * 64 + m * 16 + fr) >> 3, sq = fr & 7;
#pragma unroll
                        for (int j = 0; j < 2; ++j) { g1[j] = dppf<DPP_SHR(1)>(0.f, g[j]); g2[j] = dppf<DPP_SHR(2)>(0.f, g[j]);
                            v1[j] = dppf<DPP_SHR(1)>(0.f, v[j]); v2[j] = dppf<DPP_SHR(2)>(0.f, v[j]); }
                        if (sq < 2) { const float* sp = stf + ((size_t)b * 2 + sq) * FF2; g2 = *(const f32x2*)(sp + gcol); v2 = *(const f32x2*)(sp + vcol);
                            if (sq == 0) { g1 = *(const f32x2*)(sp + FF2 + gcol); v1 = *(const f32x2*)(sp + FF2 + vcol); } }
                    }
                    const f32x2 ug = bg + wg0 * g2 + wg1 * g1 + wg2 * g, uv = bv + wv0 * v2 + wv1 * v1 + wv2 * v;
                    keep[n][jp][ai][m] = cvt_pk_bf16(gelu_tanh(ug[0]) * uv[0], gelu_tanh(ug[1]) * uv[1]);
                }
            }
        }
        __builtin_amdgcn_sched_barrier(0);
#pragma unroll
        for (int ai = 0; ai < 2; ++ai)
#pragma unroll
            for (int m = 0; m < 4; ++m)
                *(u32x4*)(ACT + (size_t)(u.pm * 256 + ai * 128 + wr * 64 + m * 16 + fr) * FF + u.pn * 128 + cw0) = (u32x4){keep[0][0][ai][m], keep[0][1][ai][m], keep[1][0][ai][m], keep[1][1][ai][m]};
    }
    __device__ __forceinline__ void operator()(f32x4 (&acc)[2][2][4][2], const Unit& u, int wr, int wc, int fr, int fq) const {
        if (u.pm >= 64) body<true>(acc, u, wr, wc, fr, fq); else body<false>(acc, u, wr, wc, fr, fq);
    }
};

struct Args { const float* in[24]; float* out; unsigned char* ws; int ph_lo, ph_hi; };
enum { I_XP = 0, I_XS, I_SLC, I_SH, I_SPOOL, I_SFFN, I_G1, I_WIN, I_LCW, I_LCB, I_WA, I_BA, I_WX, I_BX, I_LAM, I_PW, I_PSC, I_WOUT, I_G2, I_UP, I_FCW, I_FCB, I_DOWN, I_GF };

__device__ __forceinline__ void p0_transpose_item(const float* W, int K, int N, bf16_t* WT, const float* kscale, bool up_map, LAS float* scr, int item, int lane) {
    const int nblk = N / 32, kb = item / nblk, nb = item % nblk, k0 = 64 * kb, n0 = 32 * nb;
    int drow0 = n0;
    if (up_map) { const int bj = n0 / FF, f = n0 % FF; drow0 = 256 * (f >> 7) + 128 * bj + (f & 127); }
#pragma unroll 8
    for (int i = 0; i < 32; ++i) { const int kk = 2 * i + (lane >> 5); float v = W[(size_t)(k0 + kk) * N + n0 + (lane & 31)]; if (kscale) v *= kscale[k0 + kk]; scr[kk * 33 + (lane & 31)] = v; }
    asm volatile("s_waitcnt lgkmcnt(0)" ::: "memory");
    const int c = lane & 7;
#pragma unroll
    for (int j = 0; j < 4; ++j) { const int n = (lane >> 3) + 8 * j; const LAS float* s = scr + (8 * c) * 33 + n;
        u32x4 o; o.x = cvt_pk_bf16(s[0 * 33], s[1 * 33]); o.y = cvt_pk_bf16(s[2 * 33], s[3 * 33]); o.z = cvt_pk_bf16(s[4 * 33], s[5 * 33]); o.w = cvt_pk_bf16(s[6 * 33], s[7 * 33]);
        *(u32x4*)(WT + (size_t)(drow0 + n) * K + k0 + 8 * c) = o; }
    asm volatile("s_waitcnt lgkmcnt(0)" ::: "memory");
}

struct MixCtx { const bf16_t* Z; float* HL; float* PP; bf16_t* MIX; const float* pscale; };

__device__ __forceinline__ void blk_desc(int blk, int& zrow0, bool& hasprev, int& segmask) {
    if (blk < 1024) { zrow0 = blk * 16; hasprev = (blk & 127) != 0; segmask = 15; }
    else { zrow0 = MP + (blk - 1024) * 32 + 16; hasprev = true; segmask = 7; }
}

__device__ __forceinline__ void lru_item(const MixCtx& C, int h, int blk, const bf16x8 (&WA)[4][2], const bf16x8 (&WX)[4][2], const LAS float* KC, int lane) {
    const int r = lane & 15, q = lane >> 4;
    int zrow0, segmask; bool hasprev; blk_desc(blk, zrow0, hasprev, segmask);
    const bf16_t* zp = C.Z + (size_t)(zrow0 + r) * DIN + h * 64 + q * 8;
    u32x4 zc[2], zq[2];
    zc[0] = *(const u32x4*)zp; zc[1] = *(const u32x4*)(zp + 32);
    zq[0] = zq[1] = (u32x4){0u, 0u, 0u, 0u};
    if (hasprev) { zq[0] = *(const u32x4*)(zp - 16 * DIN); zq[1] = *(const u32x4*)(zp - 16 * DIN + 32); }
    float xc[2][8]; bf16x8 Bf[2];
#pragma unroll
    for (int kb = 0; kb < 2; ++kb) {
        const LAS float* kc = KC + kb * 32 + q * 8;
        f32x4 w[4][2], bb[2];
#pragma unroll
        for (int t = 0; t < 4; ++t) { w[t][0] = *(const LAS f32x4*)(kc + t * 64); w[t][1] = *(const LAS f32x4*)(kc + t * 64 + 4); }
        bb[0] = *(const LAS f32x4*)(kc + 256); bb[1] = *(const LAS f32x4*)(kc + 260);
#pragma unroll
        for (int i2 = 0; i2 < 4; ++i2) {
            const unsigned c0 = zc[kb][i2], pv = zq[kb][i2];
            const unsigned s1 = shiftu<1>(pv, c0), s2 = shiftu<2>(pv, c0), s3 = shiftu<3>(pv, c0);
            const int e = 2 * i2, hh = e >> 2, ee = e & 3;
            xc[kb][e]     = bb[hh][ee]     + w[3][hh][ee]     * bf_lo(c0) + w[2][hh][ee]     * bf_lo(s1) + w[1][hh][ee]     * bf_lo(s2) + w[0][hh][ee]     * bf_lo(s3);
            xc[kb][e + 1] = bb[hh][ee + 1] + w[3][hh][ee + 1] * bf_hi(c0) + w[2][hh][ee + 1] * bf_hi(s1) + w[1][hh][ee + 1] * bf_hi(s2) + w[0][hh][ee + 1] * bf_hi(s3);
        }
        u32x4 pk; pk.x = cvt_pk_bf16(xc[kb][0], xc[kb][1]); pk.y = cvt_pk_bf16(xc[kb][2], xc[kb][3]); pk.z = cvt_pk_bf16(xc[kb][4], xc[kb][5]); pk.w = cvt_pk_bf16(xc[kb][6], xc[kb][7]);
        Bf[kb] = __builtin_bit_cast(bf16x8, pk);
    }
    const bool m1 = (r & segmask) < 1, m2 = (r & segmask) < 2, m4 = (r & segmask) < 4, m8 = (r & segmask) < 8;
#pragma unroll
    for (int n = 0; n < 4; ++n) {
        const int kb = n >> 1, half = n & 1;
        f32x4 R = {0.f, 0.f, 0.f, 0.f}, I = {0.f, 0.f, 0.f, 0.f};
        R = __builtin_amdgcn_mfma_f32_16x16x32_bf16(WA[n][0], Bf[0], R, 0, 0, 0); R = __builtin_amdgcn_mfma_f32_16x16x32_bf16(WA[n][1], Bf[1], R, 0, 0, 0);
        I = __builtin_amdgcn_mfma_f32_16x16x32_bf16(WX[n][0], Bf[0], I, 0, 0, 0); I = __builtin_amdgcn_mfma_f32_16x16x32_bf16(WX[n][1], Bf[1], I, 0, 0, 0);
        const LAS float* kc = KC + kb * 32 + q * 8 + half * 4;
        const f32x4 ba = *(const LAS f32x4*)(kc + 320), bx = *(const LAS f32x4*)(kc + 384), sp = *(const LAS f32x4*)(kc + 448);
        f32x4 a, b;
#pragma unroll
        for (int j = 0; j < 4; ++j) {
            const float rg = sigmoidf_(R[j] + ba[j]), ig = sigmoidf_(I[j] + bx[j]);
            const float la = -8.0f * rg * sp[j];
            a[j] = __builtin_amdgcn_exp2f(1.4426950409f * la);
            const float x2 = 2.0f * la;
            const float mm = x2 > -0.125f ? -x2 * (1.0f + x2 * (0.5f + x2 * (0.16666667f + x2 * (0.041666667f + x2 * 0.0083333333f)))) : 1.0f - a[j] * a[j];
            b[j] = sqrtf(mm) * ig * xc[kb][half * 4 + j];
        }
#define SCAN_STEP(Dd, MSK) _Pragma("unroll") for (int j = 0; j < 4; ++j) { float ap = dppf<DPP_SHR(Dd)>(1.0f, a[j]), bp = dppf<DPP_SHR(Dd)>(0.0f, b[j]); \
            if (MSK) { ap = 1.0f; bp = 0.0f; } b[j] = a[j] * bp + b[j]; a[j] = a[j] * ap; }
        SCAN_STEP(1, m1) SCAN_STEP(2, m2) SCAN_STEP(4, m4) SCAN_STEP(8, m8)
#undef SCAN_STEP
        const size_t o = (size_t)(zrow0 + r) * DL + h * 64 + kb * 32 + q * 8 + half * 4;
        *(f32x4*)(C.PP + o) = a; *(f32x4*)(C.HL + o) = b;
    }
}

__device__ __forceinline__ void pool_item(const MixCtx& C, int g, int blk, const LAS unsigned char* PWL, int lane) {
    const int r = lane & 15, q = lane >> 4;
    int zrow0, segmask; bool hasprev; blk_desc(blk, zrow0, hasprev, segmask);
    const bool prompt = blk < 1024;
    const int orow = prompt ? zrow0 + r : MP + (blk - 1024) * 8 + (r - 8);
    const bool valid = prompt || r >= 8;
    const int w = 2 << g;
    int cnt = w; if (prompt) { const int t1 = ((zrow0 + r) & 2047) + 1; cnt = t1 < w ? t1 : w; }
    const float inv = 1.0f / (float)cnt;
    const bf16_t* zp = C.Z + (size_t)(zrow0 + r) * DIN + 1024 + g * 128 + q * 8;
    bf16x8 Bf[4];
#pragma unroll
    for (int ks = 0; ks < 4; ++ks) {
        const u32x4 c = *(const u32x4*)(zp + ks * 32);
        u32x4 p = {0u, 0u, 0u, 0u}; if (hasprev) p = *(const u32x4*)(zp + ks * 32 - 16 * DIN);
        float pl[8];
#pragma unroll
        for (int e = 0; e < 8; ++e) {
            const float x = (e & 1) ? bf_hi(c[e >> 1]) : bf_lo(c[e >> 1]);
            float PS = (e & 1) ? bf_hi(p[e >> 1]) : bf_lo(p[e >> 1]);
            float S = x;
            S += shiftf<1>(PS, S);
            if (g >= 1) { PS += dppf<DPP_SHR(1)>(0.f, PS); S += shiftf<2>(PS, S); }
            if (g >= 2) { PS += dppf<DPP_SHR(2)>(0.f, PS); S += shiftf<4>(PS, S); }
            if (g >= 3) { PS += dppf<DPP_SHR(4)>(0.f, PS); S += shiftf<8>(PS, S); }
            pl[e] = S * inv - x;
        }
        u32x4 pk; pk.x = cvt_pk_bf16(pl[0], pl[1]); pk.y = cvt_pk_bf16(pl[2], pl[3]); pk.z = cvt_pk_bf16(pl[4], pl[5]); pk.w = cvt_pk_bf16(pl[6], pl[7]);
        Bf[ks] = __builtin_bit_cast(bf16x8, pk);
    }
#pragma unroll
    for (int m2 = 0; m2 < 4; ++m2) {
        f32x4 y[2];
#pragma unroll
        for (int half = 0; half < 2; ++half) {
            const int out = m2 * 32 + (r >> 2) * 8 + half * 4 + (r & 3);
            const LAS unsigned char* wrow = PWL + (g * 128 + out) * 256;
            f32x4 Dv = {0.f, 0.f, 0.f, 0.f};
#pragma unroll
            for (int ks = 0; ks < 4; ++ks) { const bf16x8 A = *(const LAS bf16x8*)(wrow + (((ks * 4 + q) ^ r) << 4)); Dv = __builtin_amdgcn_mfma_f32_16x16x32_bf16(A, Bf[ks], Dv, 0, 0, 0); }
            const f32x4 sc = *(const f32x4*)(C.pscale + g * 128 + m2 * 32 + q * 8 + half * 4);
            y[half] = Dv * sc;
        }
        if (valid) { u32x4 pk; pk.x = cvt_pk_bf16(y[0][0], y[0][1]); pk.y = cvt_pk_bf16(y[0][2], y[0][3]); pk.z = cvt_pk_bf16(y[1][0], y[1][1]); pk.w = cvt_pk_bf16(y[1][2], y[1][3]);
            *(u32x4*)(C.MIX + (size_t)orow * D + 512 + g * 128 + m2 * 32 + q * 8) = pk; }
    }
}

#define XB_TMO      128
#define XB_XCNT(j)  (256  + 64 * (j))
#define XB_XSUB(j)  (1280 + 64 * (j))
#define XB_XGEN(j)  (2304 + 64 * (j))
#define XB_TOP      3328
#define XB_TOPGEN   3392
#define XCD_BAR_WORDS 3456
#define XB_SPIN_CAP (1u << 22)
__device__ __forceinline__ unsigned xb_ld(unsigned* p)              { return __hip_atomic_load(p, __ATOMIC_RELAXED, __HIP_MEMORY_SCOPE_AGENT); }
__device__ __forceinline__ unsigned xb_add(unsigned* p, unsigned v) { return __hip_atomic_fetch_add(p, v, __ATOMIC_RELAXED, __HIP_MEMORY_SCOPE_AGENT); }
__device__ __forceinline__ unsigned xb_xcc_id() { return (unsigned)__builtin_amdgcn_s_getreg((3 << 11) | 20) & 0xFu; }
#define XB_SPIN(cond, bar) do { unsigned _sp = 0; while (cond) { __builtin_amdgcn_s_sleep(1); \
    if ((++_sp & 255u) == 0u) { if (xb_ld(&(bar)[XB_TMO])) break; if (_sp > XB_SPIN_CAP) { atomicAdd(&(bar)[XB_TMO], 1u); break; } } } } while (0)
struct XcdBarrier { unsigned* bar; unsigned x; volatile LAS unsigned* st; };
__device__ __forceinline__ XcdBarrier xcd_barrier_post(unsigned* bar, volatile LAS unsigned* st) {
    XcdBarrier b; b.bar = bar; b.x = xb_xcc_id(); b.st = st;
    if (threadIdx.x == 0) (void)xb_add(&bar[XB_XCNT(b.x)], 1u);
    return b;
}
__device__ __forceinline__ void xcd_barrier_complete(unsigned* bar, unsigned x, unsigned& nloc, unsigned& nx) {
    const unsigned G = gridDim.x * gridDim.y * gridDim.z;
    unsigned sum, cnt, mine, sp = 0u;
    for (;;) {
        sum = 0u; cnt = 0u; mine = 0u;
#pragma unroll
        for (unsigned j = 0; j < 16; ++j) { const unsigned c = xb_ld(&bar[XB_XCNT(j)]); sum += c; cnt += (c > 0u) ? 1u : 0u; mine = (j == x) ? c : mine; }
        if (sum == G) break;
        __builtin_amdgcn_s_sleep(1);
        if ((++sp & 255u) == 0u) { if (xb_ld(&bar[XB_TMO])) break; if (sp > XB_SPIN_CAP) { atomicAdd(&bar[XB_TMO], 1u); break; } }
    }
    nloc = mine > 0u ? mine : 1u; nx = cnt > 0u ? cnt : 1u;
}
__device__ __forceinline__ void xcd_barrier(const XcdBarrier& b) {
    asm volatile("s_waitcnt vmcnt(0)" ::: "memory");
    __syncthreads();
    if (threadIdx.x == 0) {
        unsigned* bar = b.bar;
        __builtin_amdgcn_s_waitcnt(0);
        unsigned nloc = b.st[0], nx = b.st[1];
        if (nloc == 0u) { xcd_barrier_complete(bar, b.x, nloc, nx); b.st[0] = nloc; b.st[1] = nx; }
        const unsigned old = xb_add(&bar[XB_XSUB(b.x)], 1u);
        const unsigned gen = old / nloc;
        if (old + 1u == (gen + 1u) * nloc) {
            __builtin_amdgcn_fence(__ATOMIC_RELEASE, "agent");
            asm volatile("s_waitcnt vmcnt(0)" ::: "memory");
            const unsigned og = xb_add(&bar[XB_TOP], 1u);
            const unsigned tg = og / nx;
            if (og + 1u == (tg + 1u) * nx) xb_add(&bar[XB_TOPGEN], 1u);
            else XB_SPIN(xb_ld(&bar[XB_TOPGEN]) == tg, bar);
            __builtin_amdgcn_fence(__ATOMIC_ACQUIRE, "agent");
            xb_add(&bar[XB_XGEN(b.x)], 1u);
            asm volatile("s_waitcnt vmcnt(0)" ::: "memory");
        } else {
            XB_SPIN(xb_ld(&bar[XB_XGEN(b.x)]) == gen, bar);
            __builtin_amdgcn_fence(__ATOMIC_ACQUIRE, "agent");
            asm volatile("s_waitcnt vmcnt(0)" ::: "memory");
        }
    }
    __syncthreads();
}

__global__ void __launch_bounds__(512, 2) fwd_kernel(Args args) {
    extern __shared__ __attribute__((aligned(16))) unsigned char lds_raw[];
    LAS unsigned char* lds = (LAS unsigned char*)lds_raw;
    cg::grid_group grid = cg::this_grid();
    const int G = gridDim.x, NGW = G * 8, NGT = G * 512;
#define TID_SETUP int tid = threadIdx.x; asm volatile("" : "+v"(tid)); const int lane = tid & 63, wave = __builtin_amdgcn_readfirstlane(tid >> 6), gw = blockIdx.x * 8 + wave, gt = blockIdx.x * 512 + tid; (void)lane; (void)gw; (void)gt;
    unsigned char* ws = args.ws; float* out = args.out;
    bf16_t* Wi_t = (bf16_t*)(ws + WS_WI); bf16_t* Wo_t = (bf16_t*)(ws + WS_WO); bf16_t* Wu_t = (bf16_t*)(ws + WS_WU); bf16_t* Wd_t = (bf16_t*)(ws + WS_WD);
    bf16_t* WA_t = (bf16_t*)(ws + WS_WA); bf16_t* WX_t = (bf16_t*)(ws + WS_WX); bf16_t* PW_t = (bf16_t*)(ws + WS_PW);
    float* rs1 = (float*)(ws + WS_RS1); float* rss2 = (float*)(ws + WS_RSS2); float* edge = (float*)(ws + WS_EDGE);
    bf16_t* XB = (bf16_t*)(ws + WS_XB); bf16_t* MIX = (bf16_t*)(ws + WS_MIX); bf16_t* Z = (bf16_t*)(ws + WS_Z);
    float* HL = (float*)(ws + WS_HL); float* PP = (float*)(ws + WS_PP); bf16_t* ACT = (bf16_t*)(ws + WS_ACT);
    const int lo = args.ph_lo, hi = args.ph_hi;
#define IN(k) (lo <= (k) && (k) < hi)
#define REPS(k) ((((REP_MASK) >> (k)) & 1) + 1)
#define SEAM(k) do { if (IN(k) && IN((k) + 1)) xcd_barrier(bar); } while (0)
    for (int u_ = threadIdx.x; u_ < 64; u_ += 512) ((LAS unsigned*)(lds + LDS_MISC))[u_] = 0u;
    __syncthreads();
    XcdBarrier bar; bar.bar = (unsigned*)ws; bar.x = 0; bar.st = (volatile LAS unsigned*)(lds + LDS_MISC);
    if (hi - lo > 1) bar = xcd_barrier_post((unsigned*)ws, (volatile LAS unsigned*)(lds + LDS_MISC));
    if (hi > 1000) grid.sync();

    if (IN(0)) for (int rep_ = 0; rep_ < REPS(0); ++rep_) {
        if (rep_) xcd_barrier(bar);
        TID_SETUP
        LAS float* scr = (LAS float*)(lds + wave * 16384);
        constexpr int I_WI = 16 * 48, I_WO = 16 * 32, I_WU = 16 * 192, I_WD = 48 * 32, I_G = 8 * 2, I_P = 4 * 8;
        constexpr int NIT = I_WI + I_WO + I_WU + I_WD + 2 * I_G + I_P;
        for (int it = gw; it < NIT; it += NGW) {
            int r = it;
            if (r < I_WU) { p0_transpose_item(args.in[I_UP], D, FF2, Wu_t, args.in[I_G2], true, scr, r, lane); continue; } r -= I_WU;
            if (r < I_WD) { p0_transpose_item(args.in[I_DOWN], FF, D, Wd_t, nullptr, false, scr, r, lane); continue; } r -= I_WD;
            if (r < I_WI) { p0_transpose_item(args.in[I_WIN], D, DIN, Wi_t, args.in[I_G1], false, scr, r, lane); continue; } r -= I_WI;
            if (r < I_WO) { p0_transpose_item(args.in[I_WOUT], D, D, Wo_t, nullptr, false, scr, r, lane); continue; } r -= I_WO;
            if (r < I_G) { p0_transpose_item(args.in[I_WA] + (r >> 1) * 4096, 64, 64, WA_t + (r >> 1) * 4096, nullptr, false, scr, r & 1, lane); continue; } r -= I_G;
            if (r < I_G) { p0_transpose_item(args.in[I_WX] + (r >> 1) * 4096, 64, 64, WX_t + (r >> 1) * 4096, nullptr, false, scr, r & 1, lane); continue; } r -= I_G;
            p0_transpose_item(args.in[I_PW] + (r >> 3) * 16384, 128, 128, PW_t + (r >> 3) * 16384, nullptr, false, scr, r & 7, lane);
        }
        for (int m = gw; m < M; m += NGW) {
            const float* xrow = m < MP ? args.in[I_XP] + (size_t)m * D : args.in[I_XS] + (size_t)(m - MP) * D;
            const f32x4* xr = (const f32x4*)xrow + lane; f32x4 v[4]; float s = 0.f;
#pragma unroll
            for (int j = 0; j < 4; ++j) { v[j] = xr[64 * j]; s += (v[j][0] * v[j][0] + v[j][1] * v[j][1]) + (v[j][2] * v[j][2] + v[j][3] * v[j][3]); }
            s = wave_sum(s);
            if (lane == 0) rs1[m] = rsqrtf(s * (1.0f / D) + EPS);
            u32x2* o8 = (u32x2*)(XB + (size_t)m * D) + lane;
#pragma unroll
            for (int j = 0; j < 4; ++j) { u32x2 w; w.x = cvt_pk_bf16(v[j][0], v[j][1]); w.y = cvt_pk_bf16(v[j][2], v[j][3]); o8[64 * j] = w; }
        }
        for (int it = gw; it < 128 * 24; it += NGW) {
            const int b = it / 24, r = it % 24;
            bf16_t* zr = Z + (size_t)(MP + b * 32 + r) * DIN;
#pragma unroll
            for (int j = 0; j < 3; ++j) {
                const int c = lane * 8 + 512 * j; u32x4 w = {0u, 0u, 0u, 0u};
                const float* src = nullptr;
                if (j == 0 && r >= 21) src = args.in[I_SLC] + ((size_t)b * 3 + (r - 21)) * 512 + c;
                if (j == 2 && r >= 9) src = args.in[I_SPOOL] + ((size_t)b * 15 + (r - 9)) * 512 + (c - 1024);
                if (src) { const f32x4 a = *(const f32x4*)src, bq = *(const f32x4*)(src + 4); w.x = cvt_pk_bf16(a[0], a[1]); w.y = cvt_pk_bf16(a[2], a[3]); w.z = cvt_pk_bf16(bq[0], bq[1]); w.w = cvt_pk_bf16(bq[2], bq[3]); }
                *(u32x4*)(zr + c) = w;
            }
        }
        for (int i = gt; i < 128 * 7 * 512; i += NGT) { const int b = i / 3584, rem = i % 3584; out[O_SPOOL + (size_t)b * 7680 + rem] = args.in[I_SPOOL][(size_t)b * 7680 + 4096 + rem]; }
    }
    SEAM(0);

    if (IN(1)) for (int rep_ = 0; rep_ < REPS(1); ++rep_) {
        if (rep_) xcd_barrier(bar);
        pg8::Gemm g{XB, Wi_t, M, DIN, D}; pg8::StaticOrder S; S.init(M, DIN, G, (int)blockIdx.x);
        EpiZ E{Z, rs1};
        pg8::gemm_phase<EpiZ, pg8::StaticOrder, true, true>(lds, g, S, E);
    }
    SEAM(1);

    if (IN(2)) for (int rep_ = 0; rep_ < REPS(2); ++rep_) {
        if (rep_) xcd_barrier(bar);
        TID_SETUP
        for (int ch = tid; ch < 8192; ch += 512) { const int row = ch >> 4, c = ch & 15, o = row & 127, key = ((o >> 3) & 3) * 4 + (o & 3);
            *(LAS u32x4*)(lds + row * 256 + ((c ^ key) << 4)) = *(const u32x4*)(PW_t + (size_t)row * 128 + c * 8); }
        __syncthreads();
        MixCtx C{Z, HL, PP, MIX, args.in[I_PSC]};
        LAS float* KC = (LAS float*)(lds + LDS_X + wave * 2048);
        {
            const int i0 = (int)((long)gw * (8 * NBLK) / NGW), i1 = (int)((long)(gw + 1) * (8 * NBLK) / NGW);
            int curh = -1; bf16x8 WA[4][2], WX[4][2];
#pragma unroll
            for (int n = 0; n < 4; ++n)
#pragma unroll
                for (int k = 0; k < 2; ++k) { WA[n][k] = (bf16x8){0, 0, 0, 0, 0, 0, 0, 0}; WX[n][k] = WA[n][k]; }
            for (int it = i0; it < i1; ++it) {
                const int h = it / NBLK, blk = it % NBLK;
                if (h != curh) {
                    curh = h;
                    asm volatile("s_waitcnt lgkmcnt(0)" ::: "memory");
                    const int ch = h * 64 + lane;
#pragma unroll
                    for (int t = 0; t < 4; ++t) KC[t * 64 + lane] = args.in[I_LCW][t * 512 + ch];
                    KC[256 + lane] = args.in[I_LCB][ch]; KC[320 + lane] = args.in[I_BA][ch]; KC[384 + lane] = args.in[I_BX][ch];
                    { const float lam = args.in[I_LAM][ch]; KC[448 + lane] = log1pf(expf(-lam)); }
                    const int rho = lane & 15, qq = lane >> 4;
#pragma unroll
                    for (int n = 0; n < 4; ++n) { const int o = (n >> 1) * 32 + (rho >> 2) * 8 + (n & 1) * 4 + (rho & 3);
#pragma unroll
                        for (int k = 0; k < 2; ++k) { WA[n][k] = *(const bf16x8*)(WA_t + (size_t)(h * 64 + o) * 64 + k * 32 + qq * 8); WX[n][k] = *(const bf16x8*)(WX_t + (size_t)(h * 64 + o) * 64 + k * 32 + qq * 8); } }
                    asm volatile("s_waitcnt lgkmcnt(0)" ::: "memory");
                }
                lru_item(C, h, blk, WA, WX, KC, lane);
                asm volatile("" ::: "memory");
            }
        }
        {
            const int gwr = NGW - 1 - gw;
            const int i0 = (int)((long)gwr * (4 * NBLK) / NGW), i1 = (int)((long)(gwr + 1) * (4 * NBLK) / NGW);
            for (int it = i0; it < i1; ++it) { pool_item(C, it / NBLK, it % NBLK, lds, lane); asm volatile("" ::: "memory"); }
        }
        __syncthreads();
    }
    SEAM(2);

    if (IN(3)) for (int rep_ = 0; rep_ < REPS(3); ++rep_) {
        if (rep_) xcd_barrier(bar);
        TID_SETUP
        for (int id = gw; id < 2048 + 1024; id += NGW) {
            if (id < 2048) {
                const int b = id >> 8, ck = (id & 255) >> 3, c = (id & 7) * 64 + lane; const size_t base = (size_t)b * 2048;
                float carry = 0.f;
                for (int k = 0; k < 4 * ck; ++k) { const size_t o = (base + 16 * k + 15) * DL + c; carry = PP[o] * carry + HL[o]; }
                float h = 0.f;
#pragma unroll 4
                for (int t = 0; t < 64; ++t) { const size_t row = base + 64 * ck + t; const size_t o = row * DL + c;
                    h = HL[o] + PP[o] * carry; if ((t & 15) == 15) carry = h;
                    const float zg = bf_one(Z[row * DIN + 512 + c]);
                    MIX[row * D + c] = (bf16_t)(cvt_pk_bf16(h * gelu_tanh(zg), 0.f) & 0xffffu); }
                if (ck == 31) out[O_PH + b * 512 + c] = h;
            } else {
                const int sid = id - 2048, b = sid >> 3, c = (sid & 7) * 64 + lane;
                const float carry = args.in[I_SH][b * 512 + c]; float h = 0.f;
#pragma unroll
                for (int s = 0; s < 8; ++s) { const size_t zr = (size_t)MP + b * 32 + 24 + s; const size_t o = zr * DL + c;
                    h = HL[o] + PP[o] * carry;
                    const float zg = bf_one(Z[zr * DIN + 512 + c]);
                    MIX[((size_t)MP + b * 8 + s) * D + c] = (bf16_t)(cvt_pk_bf16(h * gelu_tanh(zg), 0.f) & 0xffffu); }
                out[O_SH + b * 512 + c] = h;
            }
        }
        for (int i = gt; i < 8 * 3 * 512; i += NGT) { const int b = i / 1536, k = (i % 1536) >> 9, c = i & 511; out[O_PLC + i] = bf_one(Z[((size_t)b * 2048 + 2045 + k) * DIN + c]); }
        for (int i = gt; i < 8 * 15 * 512; i += NGT) { const int b = i / 7680, k = (i % 7680) >> 9, c = i & 511; out[O_PPOOL + i] = bf_one(Z[((size_t)b * 2048 + 2033 + k) * DIN + 1024 + c]); }
        for (int i = gt; i < 128 * 3 * 512; i += NGT) { const int b = i / 1536, k = (i % 1536) >> 9, c = i & 511; out[O_SLC + i] = bf_one(Z[((size_t)MP + b * 32 + 29 + k) * DIN + c]); }
        for (int i = gt; i < 128 * 8 * 512; i += NGT) { const int b = i >> 12, s = (i >> 9) & 7, c = i & 511; out[O_SPOOL + (size_t)b * 7680 + (7 + s) * 512 + c] = bf_one(Z[((size_t)MP + b * 32 + 24 + s) * DIN + 1024 + c]); }
    }
    SEAM(3);

    if (IN(4)) for (int rep_ = 0; rep_ < REPS(4); ++rep_) {
        if (rep_) xcd_barrier(bar);
        pg8::Gemm g{MIX, Wo_t, M, D, D}; pg8::StaticOrder S; S.init(M, D, G, (int)blockIdx.x);
        EpiX1 E{args.in[I_XP], args.in[I_XS], out + O_Y, XB, rss2};
        pg8::gemm_phase<EpiX1, pg8::StaticOrder, true, true>(lds, g, S, E);
    }
    SEAM(4);

    if (IN(5)) for (int rep_ = 0; rep_ < REPS(5); ++rep_) {
        if (rep_) xcd_barrier(bar);
        pg8::Gemm g{XB, Wu_t, M, FF2, D}; pg8::StaticOrder S; S.init(M, FF2, G, (int)blockIdx.x);
        EpiFfn E{ACT, rss2, args.in[I_FCW], args.in[I_FCB], args.in[I_SFFN], edge, out + O_PFFN, out + O_SFFN, lds + LDS_X};
        pg8::gemm_phase<EpiFfn, pg8::StaticOrder, true, true>(lds, g, S, E);
    }
    SEAM(5);

    if (IN(6)) for (int rep_ = 0; rep_ < REPS(6); ++rep_) {
        if (rep_) xcd_barrier(bar);
        TID_SETUP
        const float* cw = args.in[I_FCW]; const float* cb = args.in[I_FCB];
        for (int i = gt; i < 64 * FF; i += NGT) {
            const int pm = i / FF, f = i % FF;
            if ((pm & 7) == 0) continue;
            const float* L = edge + ((size_t)(pm - 1) * 4 + 2) * FF2; const float* F = edge + (size_t)pm * 4 * FF2;
            float a0, a1;
            { const float l0 = L[f], l1 = L[FF2 + f], f0 = F[f], f1 = F[FF2 + f]; const float w0 = cw[f], w1 = cw[FF2 + f], w2 = cw[2 * FF2 + f], bb = cb[f];
              a0 = bb + w0 * l0 + w1 * l1 + w2 * f0; a1 = bb + w0 * l1 + w1 * f0 + w2 * f1; }
            float v0, v1;
            { const int fv = FF + f; const float l0 = L[fv], l1 = L[FF2 + fv], f0 = F[fv], f1 = F[FF2 + fv]; const float w0 = cw[fv], w1 = cw[FF2 + fv], w2 = cw[2 * FF2 + fv], bb = cb[fv];
              v0 = bb + w0 * l0 + w1 * l1 + w2 * f0; v1 = bb + w0 * l1 + w1 * f0 + w2 * f1; }
            ACT[(size_t)(pm * 256) * FF + f] = (bf16_t)(cvt_pk_bf16(gelu_tanh(a0) * v0, 0.f) & 0xffffu);
            ACT[(size_t)(pm * 256 + 1) * FF + f] = (bf16_t)(cvt_pk_bf16(gelu_tanh(a1) * v1, 0.f) & 0xffffu);
        }
    }
    SEAM(6);

    if (IN(7)) for (int rep_ = 0; rep_ < REPS(7); ++rep_) {
        if (rep_) xcd_barrier(bar);
        pg8::Gemm g{ACT, Wd_t, M, D, FF}; pg8::StaticOrder S; S.init(M, D, G, (int)blockIdx.x);
        EpiX2 E{out + O_Y};
        pg8::gemm_phase<EpiX2, pg8::StaticOrder, true, true>(lds, g, S, E);
    }
    SEAM(7);

    if (IN(8)) for (int rep_ = 0; rep_ < REPS(8); ++rep_) {
        if (rep_) xcd_barrier(bar);
        TID_SETUP
        f32x4 gf[4];
#pragma unroll
        for (int j = 0; j < 4; ++j) gf[j] = ((const f32x4*)args.in[I_GF])[lane + 64 * j];
        for (int m = gw; m < M; m += NGW) {
            f32x4* yr = (f32x4*)(out + O_Y + (size_t)m * D) + lane; f32x4 v[4]; float s = 0.f;
#pragma unroll
            for (int j = 0; j < 4; ++j) { v[j] = yr[64 * j]; s += (v[j][0] * v[j][0] + v[j][1] * v[j][1]) + (v[j][2] * v[j][2] + v[j][3] * v[j][3]); }
            s = wave_sum(s); const float rstd = rsqrtf(s * (1.0f / D) + EPS);
#pragma unroll
            for (int j = 0; j < 4; ++j) yr[64 * j] = v[j] * rstd * gf[j];
        }
    }
#undef IN
#undef SEAM
}

extern "C" void kernel_launch(void* const* d_in, const int* in_sizes, int n_in, void* d_out, int out_size, void* d_ws, size_t ws_size, hipStream_t stream) {
    static int grid = 0;
    if (grid == 0) {
        if (n_in != 24 || ws_size < WS_END) { fprintf(stderr, "kernel_launch: unexpected n_in %d / ws %zu\n", n_in, ws_size); grid = -1; return; }
        int dev = 0, cus = 0, per_cu = 0;
        if (hipGetDevice(&dev) != hipSuccess || hipDeviceGetAttribute(&cus, hipDeviceAttributeMultiprocessorCount, dev) != hipSuccess) { grid = -1; return; }
        if (hipFuncSetAttribute((const void*)fwd_kernel, hipFuncAttributeMaxDynamicSharedMemorySize, LDS_BYTES) != hipSuccess) { fprintf(stderr, "kernel_launch: hipFuncSetAttribute failed\n"); grid = -1; return; }
        if (hipOccupancyMaxActiveBlocksPerMultiprocessor(&per_cu, (const void*)fwd_kernel, 512, LDS_BYTES) != hipSuccess || per_cu < 1) { fprintf(stderr, "kernel_launch: occupancy query says %d\n", per_cu); (void)hipGetLastError(); per_cu = 1; }
        grid = cus * 1;
    }
    if (grid < 0) return;
    Args a{};
    for (int i = 0; i < 24; ++i) a.in[i] = (const float*)d_in[i];
    a.out = (float*)d_out; a.ws = (unsigned char*)d_ws;
#if MK_N_LAUNCHES == 1
    a.ph_lo = 0; a.ph_hi = 9;
    if (hipMemsetAsync(d_ws, 0, 65536, stream) != hipSuccess) { fprintf(stderr, "kernel_launch: memset failed\n"); return; }
    void* kargs[] = {&a};
    hipError_t e = hipLaunchCooperativeKernel((const void*)fwd_kernel, dim3(grid), dim3(512), kargs, LDS_BYTES, stream);
    if (e != hipSuccess) fprintf(stderr, "cooperative launch failed: %s (grid %d)\n", hipGetErrorString(e), grid);
#else
    for (int p = 0; p < 9; ++p) { a.ph_lo = p; a.ph_hi = p + 1; hipLaunchKernelGGL(fwd_kernel, dim3(grid), dim3(512), LDS_BYTES, stream, a); }
#endif
}
```

```cpp
#include <hip/hip_runtime.h>
#include <hip/hip_cooperative_groups.h>
#include <cstdio>
#include <cstdint>
namespace cg = cooperative_groups;

#ifndef REP_MASK
#define REP_MASK 0
#endif
#ifndef MK_N_LAUNCHES
#define MK_N_LAUNCHES 1
#endif

#define LAS __attribute__((address_space(3)))
typedef unsigned short bf16_t;
typedef short bf16x8 __attribute__((ext_vector_type(8)));
typedef float f32x4 __attribute__((ext_vector_type(4)));
typedef float f32x2 __attribute__((ext_vector_type(2)));
typedef unsigned u32x4 __attribute__((ext_vector_type(4)));
typedef unsigned u32x2 __attribute__((ext_vector_type(2)));

constexpr int MP = 16384, MS = 1024, M = MP + MS, D = 1024, DIN = 1536, DL = 512, FF = 3072, FF2 = 6144;
constexpr int ZROWS = MP + 128 * 32;
constexpr int NBLK = 1024 + 128;
constexpr float EPS = 1e-6f;

constexpr size_t O_Y = 0, O_PLC = 17825792, O_PH = 17838080, O_PPOOL = 17842176, O_PFFN = 17903616,
                 O_SLC = 18001920, O_SH = 18198528, O_SPOOL = 18264064, O_SFFN = 19247104;

constexpr size_t MiB = 1u << 20;
constexpr size_t WS_WI = 1 * MiB, WS_WO = 4 * MiB, WS_WU = 6 * MiB, WS_WD = 18 * MiB;
constexpr size_t WS_WA = 24 * MiB, WS_WX = WS_WA + 65536, WS_PW = WS_WX + 65536;
constexpr size_t WS_RS1 = 25 * MiB, WS_RSS2 = WS_RS1 + 131072;
constexpr size_t WS_EDGE = 27 * MiB;
constexpr size_t WS_XB = 34 * MiB;
constexpr size_t WS_MIX = 68 * MiB;
constexpr size_t WS_Z = 102 * MiB;
constexpr size_t WS_HL = 162 * MiB, WS_PP = 202 * MiB;
constexpr size_t WS_ACT = 102 * MiB;
constexpr size_t WS_PART = 34 * MiB;
constexpr size_t WS_END = 242 * MiB;

constexpr int LDS_BYTES = 147456 + 256;
constexpr int LDS_MISC = 147456;
constexpr int LDS_X = 131072;

__device__ __forceinline__ unsigned cvt_pk_bf16(float lo, float hi) { unsigned r; asm volatile("v_cvt_pk_bf16_f32 %0, %1, %2" : "=v"(r) : "v"(lo), "v"(hi)); return r; }
__device__ __forceinline__ float bf_lo(unsigned u) { return __builtin_bit_cast(float, u << 16); }
__device__ __forceinline__ float bf_hi(unsigned u) { return __builtin_bit_cast(float, u & 0xffff0000u); }
__device__ __forceinline__ float bf_one(bf16_t u) { return __builtin_bit_cast(float, (unsigned)u << 16); }
__device__ __forceinline__ float wave_sum(float v) {
#pragma unroll
    for (int o = 1; o < 64; o <<= 1) v += __shfl_xor(v, o);
    return v;
}
#define DPP_SHR(n) (0x110 + (n))
#define DPP_ROR(n) (0x120 + (n))
template <int CTRL> __device__ __forceinline__ unsigned dppu(unsigned old, unsigned src) { return (unsigned)__builtin_amdgcn_update_dpp((int)old, (int)src, CTRL, 0xf, 0xf, false); }
template <int CTRL> __device__ __forceinline__ float dppf(float old, float src) {
    return __builtin_bit_cast(float, __builtin_amdgcn_update_dpp(__builtin_bit_cast(int, old), __builtin_bit_cast(int, src), CTRL, 0xf, 0xf, false));
}
template <int Dd> __device__ __forceinline__ unsigned shiftu(unsigned prev, unsigned cur) { return dppu<DPP_SHR(Dd)>(dppu<DPP_ROR(Dd)>(0u, prev), cur); }
template <int Dd> __device__ __forceinline__ float shiftf(float prev, float cur) { return dppf<DPP_SHR(Dd)>(dppf<DPP_ROR(Dd)>(0.f, prev), cur); }

__device__ __forceinline__ float sigmoidf_(float x) { return __builtin_amdgcn_rcpf(1.0f + __builtin_amdgcn_exp2f(-1.4426950409f * x)); }
__device__ __forceinline__ float gelu_tanh(float x) {
    const float k = -2.302208198f;
    const float p = x * (k + (k * 0.044715f) * (x * x));
    return x * __builtin_amdgcn_rcpf(1.0f + __builtin_amdgcn_exp2f(p));
}

namespace pg8 {
constexpr int BM = 256, BK = 64, HALF = 128, HTB = HALF * BK * 2, STAGE_BYTES = 8 * HTB, NXCD = 8, WGM = 8;
__host__ __device__ __forceinline__ int lds_byte(int r, int c) { const int st = (r >> 4) * 2 + (c >> 5), rr = r & 15, cc = c & 31, ob = rr * 64 + cc * 2; return st * 1024 + (ob ^ (((ob >> 9) & 1) << 5)); }
__host__ __device__ __forceinline__ void stage_rc(int b, int& R, int& C) { const int st = b / 1024, sb = b % 1024, swz = sb ^ (((sb >> 9) & 1) << 5); R = (st >> 1) * 16 + swz / 64; C = (st & 1) * 32 + (swz % 64) / 2; }
__host__ __device__ __forceinline__ int perm32(int rho) { const int n = rho >> 4, i = rho & 15; return 8 * (i >> 2) + 4 * n + (i & 3); }

struct Unit { int pm, pn, k0; };
struct Gemm { const bf16_t* A; const bf16_t* Bt; int M, N, K, ld; };

struct StaticOrder {
    int nM, nN, nwg, G, c;
    __host__ __device__ void init(int M_, int N_, int G_, int c_) { nM = M_ / BM; nN = N_ / BM; nwg = nM * nN; G = G_; c = c_; }
    __host__ __device__ bool next(int i, Unit& u) const {
        const long L = (long)i * G + c; if (L >= nwg) return false;
        int wgid = (int)L; { const int q = nwg / NXCD, r = nwg % NXCD, xcd = wgid % NXCD, off = wgid / NXCD; wgid = (xcd < r ? xcd * (q + 1) : r * (q + 1) + (xcd - r) * q) + off; }
        const int nig = WGM * nN, gid = wgid / nig, fm = gid * WGM, gsz = (nM - fm) < WGM ? (nM - fm) : WGM;
        u.pm = fm + ((wgid % nig) % gsz); u.pn = (wgid % nig) / gsz; u.k0 = 0; return true;
    }
    __device__ __forceinline__ void a_ready(const Unit&) const {}
    __device__ __forceinline__ void done(const Unit&) const {}
};

struct SplitOrder {
    int G, c, nsplit, klen;
    __host__ __device__ bool next(int i, Unit& u) const {
        const int L = i * G + c; if (L >= 16 * nsplit) return false;
        const int tile = L / nsplit, ks = L % nsplit; u.pm = 64 + (tile >> 2); u.pn = tile & 3; u.k0 = ks * klen; return true;
    }
    __device__ __forceinline__ void a_ready(const Unit&) const {}
    __device__ __forceinline__ void done(const Unit&) const {}
};

template <class Epi, class Sched, bool ALIGN_EPI = false, bool SP2 = false>
__device__ __forceinline__ void gemm_phase(LAS unsigned char* lds, const Gemm g, const Sched& S, const Epi& E) {
    const int tid = threadIdx.x, wid = __builtin_amdgcn_readfirstlane(tid >> 6), lane = tid & 63, wr = wid >> 2, wc = wid & 3, fr = lane & 15, fq = lane >> 4;
    const int K = g.ld, nt = g.K / BK;
    unsigned voffA[2], voffB[2];
#pragma unroll
    for (int i = 0; i < 2; ++i) { int R, C; stage_rc(tid * 16 + i * 8192, R, C); const int Rb = Epi::PERM ? ((R & ~31) + perm32(R & 31)) : R;
        voffA[i] = (unsigned)(R * K + C) * 2u; voffB[i] = (unsigned)(Rb * K + C) * 2u; }
    const size_t kstep = (size_t)(BK * 2);
    const size_t hstep = (size_t)HALF * K * 2;
    const size_t tstep = 2 * hstep;
    const unsigned ldsw = (unsigned)wid * 1024u;
    const int aoff = lds_byte(wr * 64 + fr, fq * 8), boff = lds_byte(wc * 32 + fr, fq * 8);
#define PG8_SA(b, h) (((b) * 2 + (h)) * HTB)
#define PG8_SB(b, h) ((4 + (b) * 2 + (h)) * HTB)
#define PG8_STAGE(bufoff, gbase, voff) do { _Pragma("unroll") for (int _i = 0; _i < 2; ++_i) \
        __builtin_amdgcn_global_load_lds((const unsigned*)((const char*)(gbase) + (voff)[_i]), (LAS unsigned*)(lds + (bufoff) + ldsw + _i * 8192), 16, 0, 0); } while (0)
#define PG8_LDA(dst, b, h) do { _Pragma("unroll") for (int m = 0; m < 4; ++m) _Pragma("unroll") for (int k = 0; k < 2; ++k) dst[m][k] = *(const LAS bf16x8*)(lds + PG8_SA(b, h) + aoff + m * 2048 + k * 1024); } while (0)
#define PG8_LDB(dst, b, h) do { _Pragma("unroll") for (int n = 0; n < 2; ++n) _Pragma("unroll") for (int k = 0; k < 2; ++k) dst[n][k] = *(const LAS bf16x8*)(lds + PG8_SB(b, h) + boff + n * 2048 + k * 1024); } while (0)
#define PG8_MMA(ai, bj, At, Bt) do { __builtin_amdgcn_s_setprio(1); _Pragma("unroll") for (int m = 0; m < 4; ++m) _Pragma("unroll") for (int n = 0; n < 2; ++n) _Pragma("unroll") for (int k = 0; k < 2; ++k) \
        acc[ai][bj][m][n] = __builtin_amdgcn_mfma_f32_16x16x32_bf16(Bt[n][k], At[m][k], acc[ai][bj][m][n], 0, 0, 0); __builtin_amdgcn_s_setprio(0); } while (0)
#define PG8_WAIT_V(n) asm volatile("s_waitcnt vmcnt(" #n ")" ::: "memory")
#define PG8_WAIT_L(n) asm volatile("s_waitcnt lgkmcnt(" #n ")" ::: "memory")
#define PG8_BAR __builtin_amdgcn_s_barrier()
#define PG8_SCHED __builtin_amdgcn_sched_barrier(0)
    Unit cur, nxt; int ui = 0;
    if (!S.next(0, cur)) return;
    f32x4 acc[2][2][4][2];
#pragma unroll
    for (int a = 0; a < 2; ++a)
#pragma unroll
        for (int b = 0; b < 2; ++b)
#pragma unroll
            for (int m = 0; m < 4; ++m)
#pragma unroll
                for (int n = 0; n < 2; ++n) acc[a][b][m][n] = (f32x4){0.f, 0.f, 0.f, 0.f};
    bf16x8 At[4][2], B0[2][2], B1[2][2];
    const char* cA = (const char*)g.A + (size_t)cur.pm * tstep + (size_t)cur.k0 * 2; const char* cB = (const char*)g.Bt + (size_t)cur.pn * tstep + (size_t)cur.k0 * 2;
    S.a_ready(cur);
    if constexpr (SP2) {
        PG8_STAGE(PG8_SB(0, 0), cB, voffB); PG8_STAGE(PG8_SB(0, 1), cB + hstep, voffB); PG8_STAGE(PG8_SA(0, 0), cA, voffA); PG8_STAGE(PG8_SA(0, 1), cA + hstep, voffA);
        if (wr == 1) PG8_BAR;
        PG8_WAIT_V(2); PG8_BAR;
        PG8_STAGE(PG8_SB(1, 0), cB + kstep, voffB); PG8_STAGE(PG8_SA(1, 0), cA + kstep, voffA); PG8_STAGE(PG8_SB(1, 1), cB + hstep + kstep, voffB);
        PG8_WAIT_V(6); PG8_BAR;
    } else {
        PG8_STAGE(PG8_SB(0, 0), cB, voffB); PG8_STAGE(PG8_SA(0, 0), cA, voffA); PG8_STAGE(PG8_SB(0, 1), cB + hstep, voffB); PG8_STAGE(PG8_SA(0, 1), cA + hstep, voffA);
        if (wr == 1) PG8_BAR;
        PG8_WAIT_V(4); PG8_BAR;
        PG8_STAGE(PG8_SB(1, 0), cB + kstep, voffB); PG8_STAGE(PG8_SA(1, 0), cA + kstep, voffA); PG8_STAGE(PG8_SB(1, 1), cB + hstep + kstep, voffB);
        PG8_WAIT_V(6); PG8_BAR;
    }
    for (;;) {
        const bool has_next = S.next(ui + 1, nxt);
        const char* nA = has_next ? (const char*)g.A + (size_t)nxt.pm * tstep + (size_t)nxt.k0 * 2 : cA; const char* nB = has_next ? (const char*)g.Bt + (size_t)nxt.pn * tstep + (size_t)nxt.k0 * 2 : cB;
        for (int t = 0; t < nt; t += 2) {
            const bool last = (t == nt - 2);
            const char* a1 = cA + (size_t)(t + 1) * kstep;
            const char* a2 = last ? nA : cA + (size_t)(t + 2) * kstep; const char* b2 = last ? nB : cB + (size_t)(t + 2) * kstep;
            const char* a3 = a2 + kstep; const char* b3 = b2 + kstep;
            if (last && has_next) S.a_ready(nxt);
            if constexpr (SP2) {
            PG8_LDB(B0, 0, 0); PG8_LDB(B1, 0, 1); PG8_SCHED; PG8_LDA(At, 0, 0); PG8_STAGE(PG8_SA(1, 1), a1 + hstep, voffA);
            PG8_WAIT_V(8); PG8_WAIT_L(0); PG8_BAR; PG8_MMA(0, 0, At, B0); PG8_MMA(0, 1, At, B1); PG8_BAR; PG8_SCHED;
            PG8_LDA(At, 0, 1); PG8_STAGE(PG8_SB(0, 0), b2, voffB); PG8_STAGE(PG8_SB(0, 1), b2 + hstep, voffB); PG8_STAGE(PG8_SA(0, 0), a2, voffA);
            PG8_WAIT_V(8); PG8_WAIT_L(0); PG8_BAR; PG8_MMA(1, 0, At, B0); PG8_MMA(1, 1, At, B1); PG8_BAR; PG8_SCHED;
            PG8_LDB(B0, 1, 0); PG8_LDB(B1, 1, 1); PG8_SCHED; PG8_LDA(At, 1, 0); PG8_STAGE(PG8_SA(0, 1), a2 + hstep, voffA);
            PG8_WAIT_V(8); PG8_WAIT_L(0); PG8_BAR; PG8_MMA(0, 0, At, B0); PG8_MMA(0, 1, At, B1); PG8_BAR; PG8_SCHED;
            PG8_LDA(At, 1, 1); PG8_STAGE(PG8_SB(1, 0), b3, voffB); PG8_STAGE(PG8_SB(1, 1), b3 + hstep, voffB); PG8_STAGE(PG8_SA(1, 0), a3, voffA);
            PG8_WAIT_V(8); PG8_WAIT_L(0); PG8_BAR; PG8_MMA(1, 0, At, B0); PG8_MMA(1, 1, At, B1); PG8_BAR; PG8_SCHED;
            } else {
            PG8_LDB(B0, 0, 0); PG8_SCHED; PG8_LDA(At, 0, 0); PG8_STAGE(PG8_SA(1, 1), a1 + hstep, voffA);
            PG8_WAIT_L(8); PG8_BAR; PG8_WAIT_L(0); PG8_MMA(0, 0, At, B0); PG8_BAR; PG8_SCHED;
            PG8_LDB(B1, 0, 1); PG8_STAGE(PG8_SB(0, 0), b2, voffB);
            PG8_BAR; PG8_WAIT_L(0); PG8_MMA(0, 1, At, B1); PG8_BAR;
            PG8_LDA(At, 0, 1); PG8_STAGE(PG8_SA(0, 0), a2, voffA);
            PG8_BAR; PG8_WAIT_L(0); PG8_MMA(1, 0, At, B0); PG8_BAR; PG8_SCHED;
            PG8_STAGE(PG8_SB(0, 1), b2 + hstep, voffB);
            PG8_WAIT_V(6); PG8_BAR; PG8_MMA(1, 1, At, B1); PG8_BAR;
            PG8_LDB(B0, 1, 0); PG8_SCHED; PG8_LDA(At, 1, 0); PG8_STAGE(PG8_SA(0, 1), a2 + hstep, voffA);
            PG8_WAIT_L(8); PG8_BAR; PG8_WAIT_L(0); PG8_MMA(0, 0, At, B0); PG8_BAR; PG8_SCHED;
            PG8_LDB(B1, 1, 1); PG8_STAGE(PG8_SB(1, 0), b3, voffB);
            PG8_BAR; PG8_WAIT_L(0); PG8_MMA(0, 1, At, B1); PG8_BAR;
            PG8_LDA(At, 1, 1); PG8_STAGE(PG8_SA(1, 0), a3, voffA);
            PG8_BAR; PG8_WAIT_L(0); PG8_MMA(1, 0, At, B0); PG8_BAR; PG8_SCHED;
            PG8_STAGE(PG8_SB(1, 1), b3 + hstep, voffB);
            PG8_WAIT_V(6); PG8_BAR; PG8_MMA(1, 1, At, B1); PG8_BAR;
            }
        }
        if constexpr (ALIGN_EPI) { if (wr == 0) PG8_BAR; }
        E(acc, cur, wr, wc, fr, fq); S.done(cur);
        if (!has_next) break;
#pragma unroll
        for (int a = 0; a < 2; ++a)
#pragma unroll
            for (int b = 0; b < 2; ++b)
#pragma unroll
                for (int m = 0; m < 4; ++m)
#pragma unroll
                    for (int n = 0; n < 2; ++n) acc[a][b][m][n] = (f32x4){0.f, 0.f, 0.f, 0.f};
        cur = nxt; cA = nA; cB = nB; ++ui;
        if constexpr (ALIGN_EPI) { if (wr == 1) PG8_BAR; }
    }
    PG8_WAIT_V(0);
    if constexpr (!ALIGN_EPI) { if (wr == 0) PG8_BAR; }
    PG8_BAR;
#undef PG8_SA
#undef PG8_SB
#undef PG8_STAGE
#undef PG8_LDA
#undef PG8_LDB
#undef PG8_MMA
#undef PG8_WAIT_V
#undef PG8_WAIT_L
#undef PG8_BAR
#undef PG8_SCHED
}
}
using pg8::Unit;

#define EPI_IDS int tid_ = threadIdx.x; asm volatile("" : "+v"(tid_)); const int wid_ = __builtin_amdgcn_readfirstlane(tid_ >> 6), wr = wid_ >> 2, wc = wid_ & 3, fr = tid_ & 15, fq = (tid_ >> 4) & 3;
struct EpiZ {
    static constexpr bool PERM = true;
    bf16_t* Z; const float* rs1;
    __device__ __forceinline__ void operator()(const f32x4 (&acc)[2][2][4][2], const Unit& u, int, int, int, int) const {
        EPI_IDS
        const int row0 = u.pm * 256 + wr * 64 + fr, col0 = u.pn * 256 + wc * 32 + 8 * fq;
#pragma unroll
        for (int ai = 0; ai < 2; ++ai)
#pragma unroll
            for (int m = 0; m < 4; ++m) {
                const int row = row0 + ai * 128 + m * 16; const float s = rs1[row];
                const int orow = row < MP ? row : MP + ((row - MP) >> 3) * 32 + 24 + (row & 7);
                bf16_t* rowp = Z + (size_t)orow * DIN + col0;
#pragma unroll
                for (int bj = 0; bj < 2; ++bj) { const f32x4 v0 = acc[ai][bj][m][0] * s, v1 = acc[ai][bj][m][1] * s;
                    u32x4 w; w.x = cvt_pk_bf16(v0[0], v0[1]); w.y = cvt_pk_bf16(v0[2], v0[3]); w.z = cvt_pk_bf16(v1[0], v1[1]); w.w = cvt_pk_bf16(v1[2], v1[3]);
                    *(u32x4*)(rowp + bj * 128) = w; }
            }
    }
};
struct EpiX1 {
    static constexpr bool PERM = true;
    const float* xp; const float* xs; float* y; bf16_t* X1B; float* rss2;
    __device__ __forceinline__ void operator()(const f32x4 (&acc)[2][2][4][2], const Unit& u, int, int, int, int) const {
        EPI_IDS
        const int row0 = u.pm * 256 + wr * 64 + fr, col0 = u.pn * 256 + wc * 32 + 8 * fq;
#pragma unroll
        for (int ai = 0; ai < 2; ++ai)
#pragma unroll
            for (int m = 0; m < 4; ++m) {
                const int row = row0 + ai * 128 + m * 16;
                const float* xr = (row < MP ? xp + (size_t)row * D : xs + (size_t)(row - MP) * D) + col0;
                float* yr = y + (size_t)row * D + col0; bf16_t* br = X1B + (size_t)row * D + col0; float ss = 0.f;
#pragma unroll
                for (int bj = 0; bj < 2; ++bj) { const f32x4 v0 = acc[ai][bj][m][0] + *(const f32x4*)(xr + bj * 128), v1 = acc[ai][bj][m][1] + *(const f32x4*)(xr + bj * 128 + 4);
                    *(f32x4*)(yr + bj * 128) = v0; *(f32x4*)(yr + bj * 128 + 4) = v1;
                    u32x4 w; w.x = cvt_pk_bf16(v0[0], v0[1]); w.y = cvt_pk_bf16(v0[2], v0[3]); w.z = cvt_pk_bf16(v1[0], v1[1]); w.w = cvt_pk_bf16(v1[2], v1[3]);
                    *(u32x4*)(br + bj * 128) = w;
                    ss += (v0[0] * v0[0] + v0[1] * v0[1]) + (v0[2] * v0[2] + v0[3] * v0[3]) + (v1[0] * v1[0] + v1[1] * v1[1]) + (v1[2] * v1[2] + v1[3] * v1[3]); }
                ss += __shfl_xor(ss, 16); ss += __shfl_xor(ss, 32);
                if (fq == 0) rss2[(size_t)row * 16 + u.pn * 4 + wc] = ss;
            }
    }
};
struct EpiX2 {
    static constexpr bool PERM = true;
    float* y;
    __device__ __forceinline__ void operator()(const f32x4 (&acc)[2][2][4][2], const Unit& u, int, int, int, int) const {
        EPI_IDS
        const int row0 = u.pm * 256 + wr * 64 + fr, col0 = u.pn * 256 + wc * 32 + 8 * fq;
#pragma unroll
        for (int ai = 0; ai < 2; ++ai)
#pragma unroll
            for (int m = 0; m < 4; ++m) {
                float* yr = y + (size_t)(row0 + ai * 128 + m * 16) * D + col0;
#pragma unroll
                for (int bj = 0; bj < 2; ++bj) { const f32x4 v0 = acc[ai][bj][m][0] + *(const f32x4*)(yr + bj * 128), v1 = acc[ai][bj][m][1] + *(const f32x4*)(yr + bj * 128 + 4);
                    *(f32x4*)(yr + bj * 128) = v0; *(f32x4*)(yr + bj * 128 + 4) = v1; }
            }
    }
};
constexpr int KSPLIT = 8;
struct EpiPart {
    static constexpr bool PERM = true;
    float* part;
    __device__ __forceinline__ void operator()(const f32x4 (&acc)[2][2][4][2], const Unit& u, int, int, int, int) const {
        EPI_IDS
        const int row0 = (u.pm - 64) * 256 + wr * 64 + fr, col0 = u.pn * 256 + wc * 32 + 8 * fq;
        float* pb = part + (size_t)(u.k0 / (FF / KSPLIT)) * MS * D;
#pragma unroll
        for (int ai = 0; ai < 2; ++ai)
#pragma unroll
            for (int m = 0; m < 4; ++m) {
                float* yr = pb + (size_t)(row0 + ai * 128 + m * 16) * D + col0;
#pragma unroll
                for (int bj = 0; bj < 2; ++bj) { *(f32x4*)(yr + bj * 128) = acc[ai][bj][m][0]; *(f32x4*)(yr + bj * 128 + 4) = acc[ai][bj][m][1]; }
            }
    }
};
struct EpiFfn {
    static constexpr bool PERM = true;
    bf16_t* ACT; const float* rss2; const float* cw; const float* cb; const float* stf; float* edge; float* outp; float* outs; LAS unsigned char* lx;
    template <bool SAMPLE>
    __device__ __forceinline__ void body(f32x4 (&acc)[2][2][4][2], const Unit& u, int, int, int, int) const {
        LAS float* RS = (LAS float*)lx; LAS float* XCH = RS + 256;
        int tid = threadIdx.x; asm volatile("" : "+v"(tid));
        const int wid = __builtin_amdgcn_readfirstlane(tid >> 6), wr = wid >> 2, wc = wid & 3, fr = tid & 15, fq = (tid >> 4) & 3;
        { const int row = tid >> 1, half = tid & 1; const f32x4* p = (const f32x4*)(rss2 + (size_t)(u.pm * 256 + row) * 16 + half * 8);
          const f32x4 a = p[0], b = p[1]; float s = ((a[0] + a[1]) + (a[2] + a[3])) + ((b[0] + b[1]) + (b[2] + b[3]));
          s += __shfl_xor(s, 1);
          if (!half) RS[row] = rsqrtf(s * (1.0f / D) + EPS); }
        asm volatile("s_waitcnt lgkmcnt(0)" ::: "memory"); __builtin_amdgcn_s_barrier(); asm volatile("" ::: "memory");
        const int cw0 = wc * 32 + 8 * fq;
        const LAS float* rsw = RS + wr * 64 + fr;
        if (!SAMPLE) {
            if (fr >= 14) {
#pragma unroll
                for (int ai = 0; ai < 2; ++ai) { const int seg = 2 * ai + wr; const float s = rsw[ai * 128 + 48];
                    if (seg < 3) {
#pragma unroll
                        for (int bj = 0; bj < 2; ++bj)
#pragma unroll
                            for (int n = 0; n < 2; ++n) *(LAS f32x4*)(XCH + (seg * 2 + (fr - 14)) * 256 + bj * 128 + cw0 + 4 * n) = acc[ai][bj][3][n] * s; } }
            }
            if (wr == 0 && fr < 2) { float* e = edge + ((size_t)u.pm * 4 + fr) * FF2 + u.pn * 128 + cw0; const float s = rsw[0];
#pragma unroll
                for (int bj = 0; bj < 2; ++bj)
#pragma unroll
                    for (int n = 0; n < 2; ++n) *(f32x4*)(e + bj * FF + 4 * n) = acc[0][bj][0][n] * s; }
            if (wr == 1 && fr >= 14) { float* e = edge + ((size_t)u.pm * 4 + 2 + (fr - 14)) * FF2 + u.pn * 128 + cw0; const float s = rsw[128 + 48];
#pragma unroll
                for (int bj = 0; bj < 2; ++bj)
#pragma unroll
                    for (int n = 0; n < 2; ++n) *(f32x4*)(e + bj * FF + 4 * n) = acc[1][bj][3][n] * s;
                if ((u.pm & 7) == 7) { float* o = outp + ((size_t)(u.pm >> 3) * 2 + (fr - 14)) * FF2 + u.pn * 128 + cw0;
#pragma unroll
                    for (int bj = 0; bj < 2; ++bj)
#pragma unroll
                        for (int n = 0; n < 2; ++n) *(f32x4*)(o + bj * FF + 4 * n) = acc[1][bj][3][n] * s; } }
        } else {
            if ((fr & 7) >= 6) {
#pragma unroll
                for (int ai = 0; ai < 2; ++ai)
#pragma unroll
                    for (int m = 0; m < 4; ++m) { const int b = ((u.pm - 64) * 256 + ai * 128 + wr * 64 + m * 16 + fr) >> 3; const float s = rsw[ai * 128 + m * 16];
                        float* o = outs + ((size_t)b * 2 + ((fr & 7) - 6)) * FF2 + u.pn * 128 + cw0;
#pragma unroll
                        for (int bj = 0; bj < 2; ++bj)
#pragma unroll
                            for (int n = 0; n < 2; ++n) *(f32x4*)(o + bj * FF + 4 * n) = acc[ai][bj][m][n] * s; }
            }
        }
        asm volatile("s_waitcnt lgkmcnt(0)" ::: "memory"); __builtin_amdgcn_s_barrier(); asm volatile("" ::: "memory");
        unsigned keep[2][2][2][4];
#pragma unroll
        for (int n = 0; n < 2; ++n)
#pragma unroll
        for (int jp = 0; jp < 2; ++jp) {
            __builtin_amdgcn_sched_barrier(0);
            const int c0 = cw0 + 4 * n + 2 * jp, gcol = u.pn * 128 + c0, vcol = FF + gcol;
            const f32x2 wg0 = *(const f32x2*)(cw + gcol), wg1 = *(const f32x2*)(cw + FF2 + gcol), wg2 = *(const f32x2*)(cw + 2 * FF2 + gcol), bg = *(const f32x2*)(cb + gcol);
            const f32x2 wv0 = *(const f32x2*)(cw + vcol), wv1 = *(const f32x2*)(cw + FF2 + vcol), wv2 = *(const f32x2*)(cw + 2 * FF2 + vcol), bv = *(const f32x2*)(cb + vcol);
            f32x2 p1g, p2g, p1v, p2v;
#pragma unroll
            for (int ai = 0; ai < 2; ++ai) {
                if (!SAMPLE) {
                    const int seg = 2 * ai + wr;
                    if (seg == 0) { p1g = p2g = p1v = p2v = (f32x2){0.f, 0.f}; }
                    else { const LAS float* xb = XCH + (seg - 1) * 512 + c0;
                        p1g = *(const LAS f32x2*)(xb + 256); p2g = *(const LAS f32x2*)(xb + (fr & 1) * 256);
                        p1v = *(const LAS f32x2*)(xb + 256 + 128); p2v = *(const LAS f32x2*)(xb + (fr & 1) * 256 + 128); }
                }
#pragma unroll
                for (int m = 0; m < 4; ++m) {
                    const float s = rsw[ai * 128 + m * 16];
                    const f32x2 g = (f32x2){acc[ai][0][m][n][2 * jp], acc[ai][0][m][n][2 * jp + 1]} * s, v = (f32x2){acc[ai][1][m][n][2 * jp], acc[ai][1][m][n][2 * jp + 1]} * s;
                    f32x2 g1, g2, v1, v2;
                    if (!SAMPLE) {
#pragma unroll
                        for (int j = 0; j < 2; ++j) { g1[j] = dppf<DPP_SHR(1)>(p1g[j], g[j]); g2[j] = dppf<DPP_SHR(2)>(p2g[j], g[j]);
                            v1[j] = dppf<DPP_SHR(1)>(p1v[j], v[j]); v2[j] = dppf<DPP_SHR(2)>(p2v[j], v[j]); }
#pragma unroll
                        for (int j = 0; j < 2; ++j) { p1g[j] = dppf<DPP_ROR(1)>(0.f, g[j]); p2g[j] = dppf<DPP_ROR(2)>(0.f, g[j]);
                            p1v[j] = dppf<DPP_ROR(1)>(0.f, v[j]); p2v[j] = dppf<DPP_ROR(2)>(0.f, v[j]); }
                    } else {
                        const int b = ((u.pm - 64) * 256 + ai * 128 + wr * 64 + m * 16 + fr) >> 3, sq = fr & 7;
#pragma unroll
                        for (int j = 0; j < 2; ++j) { g1[j] = dppf<DPP_SHR(1)>(0.f, g[j]); g2[j] = dppf<DPP_SHR(2)>(0.f, g[j]);
                            v1[j] = dppf<DPP_SHR(1)>(0.f, v[j]); v2[j] = dppf<DPP_SHR(2)>(0.f, v[j]); }
                        if (sq < 2) { const float* sp = stf + ((size_t)b * 2 + sq) * FF2; g2 = *(const f32x2*)(sp + gcol); v2 = *(const f32x2*)(sp + vcol);
                            if (sq == 0) { g1 = *(const f32x2*)(sp + FF2 + gcol); v1 = *(const f32x2*)(sp + FF2 + vcol); } }
                    }
                    const f32x2 ug = bg + wg0 * g2 + wg1 * g1 + wg2 * g, uv = bv + wv0 * v2 + wv1 * v1 + wv2 * v;
                    keep[n][jp][ai][m] = cvt_pk_bf16(gelu_tanh(ug[0]) * uv[0], gelu_tanh(ug[1]) * uv[1]);
                }
            }
        }
        __builtin_amdgcn_sched_barrier(0);
#pragma unroll
        for (int ai = 0; ai < 2; ++ai)
#pragma unroll
            for (int m = 0; m < 4; ++m)
                *(u32x4*)(ACT + (size_t)(u.pm * 256 + ai * 128 + wr * 64 + m * 16 + fr) * FF + u.pn * 128 + cw0) = (u32x4){keep[0][0][ai][m], keep[0][1][ai][m], keep[1][0][ai][m], keep[1][1][ai][m]};
    }
    __device__ __forceinline__ void operator()(f32x4 (&acc)[2][2][4][2], const Unit& u, int wr, int wc, int fr, int fq) const {
        if (u.pm >= 64) body<true>(acc, u, wr, wc, fr, fq); else body<false>(acc, u, wr, wc, fr, fq);
    }
};

struct Args { const float* in[24]; float* out; unsigned char* ws; int ph_lo, ph_hi; };
enum { I_XP = 0, I_XS, I_SLC, I_SH, I_SPOOL, I_SFFN, I_G1, I_WIN, I_LCW, I_LCB, I_WA, I_BA, I_WX, I_BX, I_LAM, I_PW, I_PSC, I_WOUT, I_G2, I_UP, I_FCW, I_FCB, I_DOWN, I_GF };

__device__ __forceinline__ void p0_transpose_item(const float* W, int K, int N, bf16_t* WT, const float* kscale, bool up_map, LAS float* scr, int item, int lane) {
    const int nblk = N / 32, kb = item / nblk, nb = item % nblk, k0 = 64 * kb, n0 = 32 * nb;
    int drow0 = n0;
    if (up_map) { const int bj = n0 / FF, f = n0 % FF; drow0 = 256 * (f >> 7) + 128 * bj + (f & 127); }
    float tv[32];
#pragma unroll
    for (int i = 0; i < 32; ++i) { const int kk = 2 * i + (lane >> 5); tv[i] = W[(size_t)(k0 + kk) * N + n0 + (lane & 31)]; }
    if (kscale) {
#pragma unroll
        for (int i = 0; i < 32; ++i) tv[i] *= kscale[k0 + 2 * i + (lane >> 5)];
    }
#pragma unroll
    for (int i = 0; i < 32; ++i) scr[(2 * i + (lane >> 5)) * 33 + (lane & 31)] = tv[i];
    asm volatile("s_waitcnt lgkmcnt(0)" ::: "memory");
    const int c = lane & 7;
#pragma unroll
    for (int j = 0; j < 4; ++j) { const int n = (lane >> 3) + 8 * j; const LAS float* s = scr + (8 * c) * 33 + n;
        u32x4 o; o.x = cvt_pk_bf16(s[0 * 33], s[1 * 33]); o.y = cvt_pk_bf16(s[2 * 33], s[3 * 33]); o.z = cvt_pk_bf16(s[4 * 33], s[5 * 33]); o.w = cvt_pk_bf16(s[6 * 33], s[7 * 33]);
        *(u32x4*)(WT + (size_t)(drow0 + n) * K + k0 + 8 * c) = o; }
    asm volatile("s_waitcnt lgkmcnt(0)" ::: "memory");
}

struct MixCtx { const bf16_t* Z; float* HL; float* PP; bf16_t* MIX; const float* pscale; };

__device__ __forceinline__ void blk_desc(int blk, int& zrow0, bool& hasprev, int& segmask) {
    if (blk < 1024) { zrow0 = blk * 16; hasprev = (blk & 127) != 0; segmask = 15; }
    else { zrow0 = MP + (blk - 1024) * 32 + 16; hasprev = true; segmask = 7; }
}

__device__ __forceinline__ void lru_item(const MixCtx& C, int h, int blk, const bf16x8 (&WA)[4][2], const bf16x8 (&WX)[4][2], const LAS float* KC, int lane) {
    const int r = lane & 15, q = lane >> 4;
    int zrow0, segmask; bool hasprev; blk_desc(blk, zrow0, hasprev, segmask);
    const bf16_t* zp = C.Z + (size_t)(zrow0 + r) * DIN + h * 64 + q * 8;
    u32x4 zc[2], zq[2];
    zc[0] = *(const u32x4*)zp; zc[1] = *(const u32x4*)(zp + 32);
    zq[0] = zq[1] = (u32x4){0u, 0u, 0u, 0u};
    if (hasprev) { zq[0] = *(const u32x4*)(zp - 16 * DIN); zq[1] = *(const u32x4*)(zp - 16 * DIN + 32); }
    float xc[2][8]; bf16x8 Bf[2];
#pragma unroll
    for (int kb = 0; kb < 2; ++kb) {
        const LAS float* kc = KC + kb * 32 + q * 8;
        f32x4 w[4][2], bb[2];
#pragma unroll
        for (int t = 0; t < 4; ++t) { w[t][0] = *(const LAS f32x4*)(kc + t * 64); w[t][1] = *(const LAS f32x4*)(kc + t * 64 + 4); }
        bb[0] = *(const LAS f32x4*)(kc + 256); bb[1] = *(const LAS f32x4*)(kc + 260);
#pragma unroll
        for (int i2 = 0; i2 < 4; ++i2) {
            const unsigned c0 = zc[kb][i2], pv = zq[kb][i2];
            const unsigned s1 = shiftu<1>(pv, c0), s2 = shiftu<2>(pv, c0), s3 = shiftu<3>(pv, c0);
            const int e = 2 * i2, hh = e >> 2, ee = e & 3;
            xc[kb][e]     = bb[hh][ee]     + w[3][hh][ee]     * bf_lo(c0) + w[2][hh][ee]     * bf_lo(s1) + w[1][hh][ee]     * bf_lo(s2) + w[0][hh][ee]     * bf_lo(s3);
            xc[kb][e + 1] = bb[hh][ee + 1] + w[3][hh][ee + 1] * bf_hi(c0) + w[2][hh][ee + 1] * bf_hi(s1) + w[1][hh][ee + 1] * bf_hi(s2) + w[0][hh][ee + 1] * bf_hi(s3);
        }
        u32x4 pk; pk.x = cvt_pk_bf16(xc[kb][0], xc[kb][1]); pk.y = cvt_pk_bf16(xc[kb][2], xc[kb][3]); pk.z = cvt_pk_bf16(xc[kb][4], xc[kb][5]); pk.w = cvt_pk_bf16(xc[kb][6], xc[kb][7]);
        Bf[kb] = __builtin_bit_cast(bf16x8, pk);
    }
    const bool m1 = (r & segmask) < 1, m2 = (r & segmask) < 2, m4 = (r & segmask) < 4, m8 = (r & segmask) < 8;
#pragma unroll
    for (int n = 0; n < 4; ++n) {
        const int kb = n >> 1, half = n & 1;
        f32x4 R = {0.f, 0.f, 0.f, 0.f}, I = {0.f, 0.f, 0.f, 0.f};
        R = __builtin_amdgcn_mfma_f32_16x16x32_bf16(WA[n][0], Bf[0], R, 0, 0, 0); R = __builtin_amdgcn_mfma_f32_16x16x32_bf16(WA[n][1], Bf[1], R, 0, 0, 0);
        I = __builtin_amdgcn_mfma_f32_16x16x32_bf16(WX[n][0], Bf[0], I, 0, 0, 0); I = __builtin_amdgcn_mfma_f32_16x16x32_bf16(WX[n][1], Bf[1], I, 0, 0, 0);
        const LAS float* kc = KC + kb * 32 + q * 8 + half * 4;
        const f32x4 ba = *(const LAS f32x4*)(kc + 320), bx = *(const LAS f32x4*)(kc + 384), sp = *(const LAS f32x4*)(kc + 448);
        f32x4 a, b;
#pragma unroll
        for (int j = 0; j < 4; ++j) {
            const float rg = sigmoidf_(R[j] + ba[j]), ig = sigmoidf_(I[j] + bx[j]);
            const float la = -8.0f * rg * sp[j];
            a[j] = __builtin_amdgcn_exp2f(1.4426950409f * la);
            const float x2 = 2.0f * la;
            const float mm = x2 > -0.125f ? -x2 * (1.0f + x2 * (0.5f + x2 * (0.16666667f + x2 * (0.041666667f + x2 * 0.0083333333f)))) : 1.0f - a[j] * a[j];
            b[j] = sqrtf(mm) * ig * xc[kb][half * 4 + j];
        }
#define SCAN_STEP(Dd, MSK) _Pragma("unroll") for (int j = 0; j < 4; ++j) { float ap = dppf<DPP_SHR(Dd)>(1.0f, a[j]), bp = dppf<DPP_SHR(Dd)>(0.0f, b[j]); \
            if (MSK) { ap = 1.0f; bp = 0.0f; } b[j] = a[j] * bp + b[j]; a[j] = a[j] * ap; }
        SCAN_STEP(1, m1) SCAN_STEP(2, m2) SCAN_STEP(4, m4) SCAN_STEP(8, m8)
#undef SCAN_STEP
        const size_t o = (size_t)(zrow0 + r) * DL + h * 64 + kb * 32 + q * 8 + half * 4;
        *(f32x4*)(C.PP + o) = a; *(f32x4*)(C.HL + o) = b;
    }
}

__device__ __forceinline__ void pool_item(const MixCtx& C, int g, int blk, const LAS unsigned char* PWL, int lane) {
    const int r = lane & 15, q = lane >> 4;
    int zrow0, segmask; bool hasprev; blk_desc(blk, zrow0, hasprev, segmask);
    const bool prompt = blk < 1024;
    const int orow = prompt ? zrow0 + r : MP + (blk - 1024) * 8 + (r - 8);
    const bool valid = prompt || r >= 8;
    const int w = 2 << g;
    int cnt = w; if (prompt) { const int t1 = ((zrow0 + r) & 2047) + 1; cnt = t1 < w ? t1 : w; }
    const float inv = 1.0f / (float)cnt;
    const bf16_t* zp = C.Z + (size_t)(zrow0 + r) * DIN + 1024 + g * 128 + q * 8;
    bf16x8 Bf[4];
#pragma unroll
    for (int ks = 0; ks < 4; ++ks) {
        const u32x4 c = *(const u32x4*)(zp + ks * 32);
        u32x4 p = {0u, 0u, 0u, 0u}; if (hasprev) p = *(const u32x4*)(zp + ks * 32 - 16 * DIN);
        float pl[8];
#pragma unroll
        for (int e = 0; e < 8; ++e) {
            const float x = (e & 1) ? bf_hi(c[e >> 1]) : bf_lo(c[e >> 1]);
            float PS = (e & 1) ? bf_hi(p[e >> 1]) : bf_lo(p[e >> 1]);
            float S = x;
            S += shiftf<1>(PS, S);
            if (g >= 1) { PS += dppf<DPP_SHR(1)>(0.f, PS); S += shiftf<2>(PS, S); }
            if (g >= 2) { PS += dppf<DPP_SHR(2)>(0.f, PS); S += shiftf<4>(PS, S); }
            if (g >= 3) { PS += dppf<DPP_SHR(4)>(0.f, PS); S += shiftf<8>(PS, S); }
            pl[e] = S * inv - x;
        }
        u32x4 pk; pk.x = cvt_pk_bf16(pl[0], pl[1]); pk.y = cvt_pk_bf16(pl[2], pl[3]); pk.z = cvt_pk_bf16(pl[4], pl[5]); pk.w = cvt_pk_bf16(pl[6], pl[7]);
        Bf[ks] = __builtin_bit_cast(bf16x8, pk);
    }
#pragma unroll
    for (int m2 = 0; m2 < 4; ++m2) {
        f32x4 y[2];
#pragma unroll
        for (int half = 0; half < 2; ++half) {
            const int out = m2 * 32 + (r >> 2) * 8 + half * 4 + (r & 3);
            const LAS unsigned char* wrow = PWL + (g * 128 + out) * 256;
            f32x4 Dv = {0.f, 0.f, 0.f, 0.f};
#pragma unroll
            for (int ks = 0; ks < 4; ++ks) { const bf16x8 A = *(const LAS bf16x8*)(wrow + (((ks * 4 + q) ^ r) << 4)); Dv = __builtin_amdgcn_mfma_f32_16x16x32_bf16(A, Bf[ks], Dv, 0, 0, 0); }
            const f32x4 sc = *(const f32x4*)(C.pscale + g * 128 + m2 * 32 + q * 8 + half * 4);
            y[half] = Dv * sc;
        }
        if (valid) { u32x4 pk; pk.x = cvt_pk_bf16(y[0][0], y[0][1]); pk.y = cvt_pk_bf16(y[0][2], y[0][3]); pk.z = cvt_pk_bf16(y[1][0], y[1][1]); pk.w = cvt_pk_bf16(y[1][2], y[1][3]);
            *(u32x4*)(C.MIX + (size_t)orow * D + 512 + g * 128 + m2 * 32 + q * 8) = pk; }
    }
}

#define XB_TMO      128
#define XB_XCNT(j)  (256  + 64 * (j))
#define XB_XSUB(j)  (1280 + 64 * (j))
#define XB_XGEN(j)  (2304 + 64 * (j))
#define XB_TOP      3328
#define XB_TOPGEN   3392
#define XCD_BAR_WORDS 3456
#define XB_SPIN_CAP (1u << 22)
__device__ __forceinline__ unsigned xb_ld(unsigned* p)              { return __hip_atomic_load(p, __ATOMIC_RELAXED, __HIP_MEMORY_SCOPE_AGENT); }
__device__ __forceinline__ unsigned xb_add(unsigned* p, unsigned v) { return __hip_atomic_fetch_add(p, v, __ATOMIC_RELAXED, __HIP_MEMORY_SCOPE_AGENT); }
__device__ __forceinline__ unsigned xb_xcc_id() { return (unsigned)__builtin_amdgcn_s_getreg((3 << 11) | 20) & 0xFu; }
#define XB_SPIN(cond, bar) do { unsigned _sp = 0; while (cond) { __builtin_amdgcn_s_sleep(1); \
    if ((++_sp & 255u) == 0u) { if (xb_ld(&(bar)[XB_TMO])) break; if (_sp > XB_SPIN_CAP) { atomicAdd(&(bar)[XB_TMO], 1u); break; } } } } while (0)
struct XcdBarrier { unsigned* bar; unsigned x; volatile LAS unsigned* st; };
__device__ __forceinline__ XcdBarrier xcd_barrier_post(unsigned* bar, volatile LAS unsigned* st) {
    XcdBarrier b; b.bar = bar; b.x = xb_xcc_id(); b.st = st;
    if (threadIdx.x == 0) (void)xb_add(&bar[XB_XCNT(b.x)], 1u);
    return b;
}
__device__ __forceinline__ void xcd_barrier_complete(unsigned* bar, unsigned x, unsigned& nloc, unsigned& nx) {
    const unsigned G = gridDim.x * gridDim.y * gridDim.z;
    unsigned sum, cnt, mine, sp = 0u;
    for (;;) {
        sum = 0u; cnt = 0u; mine = 0u;
#pragma unroll
        for (unsigned j = 0; j < 16; ++j) { const unsigned c = xb_ld(&bar[XB_XCNT(j)]); sum += c; cnt += (c > 0u) ? 1u : 0u; mine = (j == x) ? c : mine; }
        if (sum == G) break;
        __builtin_amdgcn_s_sleep(1);
        if ((++sp & 255u) == 0u) { if (xb_ld(&bar[XB_TMO])) break; if (sp > XB_SPIN_CAP) { atomicAdd(&bar[XB_TMO], 1u); break; } }
    }
    nloc = mine > 0u ? mine : 1u; nx = cnt > 0u ? cnt : 1u;
}
__device__ __forceinline__ void xcd_barrier(const XcdBarrier& b) {
    asm volatile("s_waitcnt vmcnt(0)" ::: "memory");
    __syncthreads();
    if (threadIdx.x == 0) {
        unsigned* bar = b.bar;
        __builtin_amdgcn_s_waitcnt(0);
        unsigned nloc = b.st[0], nx = b.st[1];
        if (nloc == 0u) { xcd_barrier_complete(bar, b.x, nloc, nx); b.st[0] = nloc; b.st[1] = nx; }
        const unsigned old = xb_add(&bar[XB_XSUB(b.x)], 1u);
        const unsigned gen = old / nloc;
        if (old + 1u == (gen + 1u) * nloc) {
            __builtin_amdgcn_fence(__ATOMIC_RELEASE, "agent");
            asm volatile("s_waitcnt vmcnt(0)" ::: "memory");
            const unsigned og = xb_add(&bar[XB_TOP], 1u);
            const unsigned tg = og / nx;
            if (og + 1u == (tg + 1u) * nx) xb_add(&bar[XB_TOPGEN], 1u);
            else XB_SPIN(xb_ld(&bar[XB_TOPGEN]) == tg, bar);
            __builtin_amdgcn_fence(__ATOMIC_ACQUIRE, "agent");
            xb_add(&bar[XB_XGEN(b.x)], 1u);
            asm volatile("s_waitcnt vmcnt(0)" ::: "memory");
        } else {
            XB_SPIN(xb_ld(&bar[XB_XGEN(b.x)]) == gen, bar);
            __builtin_amdgcn_fence(__ATOMIC_ACQUIRE, "agent");
            asm volatile("s_waitcnt vmcnt(0)" ::: "memory");
        }
    }
    __syncthreads();
}

__global__ void __launch_bounds__(512, 2) fwd_kernel(Args args) {
    extern __shared__ __attribute__((aligned(16))) unsigned char lds_raw[];
    LAS unsigned char* lds = (LAS unsigned char*)lds_raw;
    cg::grid_group grid = cg::this_grid();
    const int G = gridDim.x, NGW = G * 8, NGT = G * 512;
#define TID_SETUP int tid = threadIdx.x; asm volatile("" : "+v"(tid)); const int lane = tid & 63, wave = __builtin_amdgcn_readfirstlane(tid >> 6), gw = blockIdx.x * 8 + wave, gt = blockIdx.x * 512 + tid; (void)lane; (void)gw; (void)gt;
    unsigned char* ws = args.ws; float* out = args.out;
    bf16_t* Wi_t = (bf16_t*)(ws + WS_WI); bf16_t* Wo_t = (bf16_t*)(ws + WS_WO); bf16_t* Wu_t = (bf16_t*)(ws + WS_WU); bf16_t* Wd_t = (bf16_t*)(ws + WS_WD);
    bf16_t* WA_t = (bf16_t*)(ws + WS_WA); bf16_t* WX_t = (bf16_t*)(ws + WS_WX); bf16_t* PW_t = (bf16_t*)(ws + WS_PW);
    float* rs1 = (float*)(ws + WS_RS1); float* rss2 = (float*)(ws + WS_RSS2); float* edge = (float*)(ws + WS_EDGE);
    bf16_t* XB = (bf16_t*)(ws + WS_XB); bf16_t* MIX = (bf16_t*)(ws + WS_MIX); bf16_t* Z = (bf16_t*)(ws + WS_Z);
    float* HL = (float*)(ws + WS_HL); float* PP = (float*)(ws + WS_PP); bf16_t* ACT = (bf16_t*)(ws + WS_ACT); float* part = (float*)(ws + WS_PART);
    const int lo = args.ph_lo, hi = args.ph_hi;
#define IN(k) (lo <= (k) && (k) < hi)
#define REPS(k) ((((REP_MASK) >> (k)) & 1) + 1)
#define SEAM(k) do { if (IN(k) && IN((k) + 1)) xcd_barrier(bar); } while (0)
    for (int u_ = threadIdx.x; u_ < 64; u_ += 512) ((LAS unsigned*)(lds + LDS_MISC))[u_] = 0u;
    __syncthreads();
    XcdBarrier bar; bar.bar = (unsigned*)ws; bar.x = 0; bar.st = (volatile LAS unsigned*)(lds + LDS_MISC);
    if (hi - lo > 1) bar = xcd_barrier_post((unsigned*)ws, (volatile LAS unsigned*)(lds + LDS_MISC));
    if (hi > 1000) grid.sync();

    if (IN(0)) for (int rep_ = 0; rep_ < REPS(0); ++rep_) {
        if (rep_) xcd_barrier(bar);
        TID_SETUP
        LAS float* scr = (LAS float*)(lds + wave * 16384);
        constexpr int I_WI = 16 * 48, I_G = 8 * 2, I_P = 4 * 8;
        constexpr int NIT = I_WI + 2 * I_G + I_P;
        for (int it = gw; it < NIT; it += NGW) {
            int r = it;
            if (r < I_WI) { p0_transpose_item(args.in[I_WIN], D, DIN, Wi_t, args.in[I_G1], false, scr, r, lane); continue; } r -= I_WI;
            if (r < I_G) { p0_transpose_item(args.in[I_WA] + (r >> 1) * 4096, 64, 64, WA_t + (r >> 1) * 4096, nullptr, false, scr, r & 1, lane); continue; } r -= I_G;
            if (r < I_G) { p0_transpose_item(args.in[I_WX] + (r >> 1) * 4096, 64, 64, WX_t + (r >> 1) * 4096, nullptr, false, scr, r & 1, lane); continue; } r -= I_G;
            p0_transpose_item(args.in[I_PW] + (r >> 3) * 16384, 128, 128, PW_t + (r >> 3) * 16384, nullptr, false, scr, r & 7, lane);
        }
        for (int m0 = gw; m0 < M; m0 += 2 * NGW) {
            const int m1 = m0 + NGW; const bool two = m1 < M; const int m1c = two ? m1 : m0;
            const float* xrow0 = m0 < MP ? args.in[I_XP] + (size_t)m0 * D : args.in[I_XS] + (size_t)(m0 - MP) * D;
            const float* xrow1 = m1c < MP ? args.in[I_XP] + (size_t)m1c * D : args.in[I_XS] + (size_t)(m1c - MP) * D;
            const f32x4* xr0 = (const f32x4*)xrow0 + lane; const f32x4* xr1 = (const f32x4*)xrow1 + lane; f32x4 v0[4], v1[4]; float s0 = 0.f, s1 = 0.f;
#pragma unroll
            for (int j = 0; j < 4; ++j) { v0[j] = xr0[64 * j]; v1[j] = xr1[64 * j]; }
#pragma unroll
            for (int j = 0; j < 4; ++j) { s0 += (v0[j][0] * v0[j][0] + v0[j][1] * v0[j][1]) + (v0[j][2] * v0[j][2] + v0[j][3] * v0[j][3]);
                                          s1 += (v1[j][0] * v1[j][0] + v1[j][1] * v1[j][1]) + (v1[j][2] * v1[j][2] + v1[j][3] * v1[j][3]); }
#pragma unroll
            for (int o = 1; o < 64; o <<= 1) { s0 += __shfl_xor(s0, o); s1 += __shfl_xor(s1, o); }
            if (lane == 0) { rs1[m0] = rsqrtf(s0 * (1.0f / D) + EPS); if (two) rs1[m1] = rsqrtf(s1 * (1.0f / D) + EPS); }
            u32x2* o0 = (u32x2*)(XB + (size_t)m0 * D) + lane; u32x2* o1 = (u32x2*)(XB + (size_t)m1c * D) + lane;
#pragma unroll
            for (int j = 0; j < 4; ++j) { u32x2 w; w.x = cvt_pk_bf16(v0[j][0], v0[j][1]); w.y = cvt_pk_bf16(v0[j][2], v0[j][3]); o0[64 * j] = w; }
            if (two) {
#pragma unroll
                for (int j = 0; j < 4; ++j) { u32x2 w; w.x = cvt_pk_bf16(v1[j][0], v1[j][1]); w.y = cvt_pk_bf16(v1[j][2], v1[j][3]); o1[64 * j] = w; } }
        }
        for (int it = gw; it < 128 * 24; it += NGW) {
            const int b = it / 24, r = it % 24;
            bf16_t* zr = Z + (size_t)(MP + b * 32 + r) * DIN;
#pragma unroll
            for (int j = 0; j < 3; ++j) {
                const int c = lane * 8 + 512 * j; u32x4 w = {0u, 0u, 0u, 0u};
                const float* src = nullptr;
                if (j == 0 && r >= 21) src = args.in[I_SLC] + ((size_t)b * 3 + (r - 21)) * 512 + c;
                if (j == 2 && r >= 9) src = args.in[I_SPOOL] + ((size_t)b * 15 + (r - 9)) * 512 + (c - 1024);
                if (src) { const f32x4 a = *(const f32x4*)src, bq = *(const f32x4*)(src + 4); w.x = cvt_pk_bf16(a[0], a[1]); w.y = cvt_pk_bf16(a[2], a[3]); w.z = cvt_pk_bf16(bq[0], bq[1]); w.w = cvt_pk_bf16(bq[2], bq[3]); }
                *(u32x4*)(zr + c) = w;
            }
        }
        for (int i = gt; i < 128 * 7 * 512; i += NGT) { const int b = i / 3584, rem = i % 3584; out[O_SPOOL + (size_t)b * 7680 + rem] = args.in[I_SPOOL][(size_t)b * 7680 + 4096 + rem]; }
    }
    SEAM(0);

    if (IN(1)) for (int rep_ = 0; rep_ < REPS(1); ++rep_) {
        if (rep_) xcd_barrier(bar);
        pg8::Gemm g{XB, Wi_t, M, DIN, D, D}; pg8::StaticOrder S; S.init(M, DIN, G, (int)blockIdx.x);
        EpiZ E{Z, rs1};
        pg8::gemm_phase<EpiZ, pg8::StaticOrder, true, true>(lds, g, S, E);
        {
            const int nun = (M / 256) * (DIN / 256), first = nun - G;
            const int c0 = (first > 0 && first < G) ? first : 0, nhelp = G - c0;
            if ((int)blockIdx.x >= c0) {
                int tid = threadIdx.x; asm volatile("" : "+v"(tid)); const int lane = tid & 63, wave = __builtin_amdgcn_readfirstlane(tid >> 6);
                LAS float* scr = (LAS float*)(lds + wave * 16384);
                for (int it = ((int)blockIdx.x - c0) * 8 + wave; it < 16 * 32; it += nhelp * 8) p0_transpose_item(args.in[I_WOUT], D, D, Wo_t, nullptr, false, scr, it, lane);
            }
        }
    }
    SEAM(1);

    if (IN(2)) for (int rep_ = 0; rep_ < REPS(2); ++rep_) {
        if (rep_) xcd_barrier(bar);
        TID_SETUP
        for (int ch = tid; ch < 8192; ch += 512) { const int row = ch >> 4, c = ch & 15, o = row & 127, key = ((o >> 3) & 3) * 4 + (o & 3);
            *(LAS u32x4*)(lds + row * 256 + ((c ^ key) << 4)) = *(const u32x4*)(PW_t + (size_t)row * 128 + c * 8); }
        __syncthreads();
        MixCtx C{Z, HL, PP, MIX, args.in[I_PSC]};
        LAS float* KC = (LAS float*)(lds + LDS_X + wave * 2048);
        {
            const int i0 = (int)((long)gw * (8 * NBLK) / NGW), i1 = (int)((long)(gw + 1) * (8 * NBLK) / NGW);
            int curh = -1; bf16x8 WA[4][2], WX[4][2];
#pragma unroll
            for (int n = 0; n < 4; ++n)
#pragma unroll
                for (int k = 0; k < 2; ++k) { WA[n][k] = (bf16x8){0, 0, 0, 0, 0, 0, 0, 0}; WX[n][k] = WA[n][k]; }
            for (int it = i0; it < i1; ++it) {
                const int h = it / NBLK, blk = it % NBLK;
                if (h != curh) {
                    curh = h;
                    asm volatile("s_waitcnt lgkmcnt(0)" ::: "memory");
                    const int ch = h * 64 + lane;
#pragma unroll
                    for (int t = 0; t < 4; ++t) KC[t * 64 + lane] = args.in[I_LCW][t * 512 + ch];
                    KC[256 + lane] = args.in[I_LCB][ch]; KC[320 + lane] = args.in[I_BA][ch]; KC[384 + lane] = args.in[I_BX][ch];
                    { const float lam = args.in[I_LAM][ch]; KC[448 + lane] = log1pf(expf(-lam)); }
                    const int rho = lane & 15, qq = lane >> 4;
#pragma unroll
                    for (int n = 0; n < 4; ++n) { const int o = (n >> 1) * 32 + (rho >> 2) * 8 + (n & 1) * 4 + (rho & 3);
#pragma unroll
                        for (int k = 0; k < 2; ++k) { WA[n][k] = *(const bf16x8*)(WA_t + (size_t)(h * 64 + o) * 64 + k * 32 + qq * 8); WX[n][k] = *(const bf16x8*)(WX_t + (size_t)(h * 64 + o) * 64 + k * 32 + qq * 8); } }
                    asm volatile("s_waitcnt lgkmcnt(0)" ::: "memory");
                }
                lru_item(C, h, blk, WA, WX, KC, lane);
                asm volatile("" ::: "memory");
            }
        }
        {
            const int gwr = NGW - 1 - gw;
            const int i0 = (int)((long)gwr * (4 * NBLK) / NGW), i1 = (int)((long)(gwr + 1) * (4 * NBLK) / NGW);
            for (int it = i0; it < i1; ++it) { pool_item(C, it / NBLK, it % NBLK, lds, lane); asm volatile("" ::: "memory"); }
        }
        __syncthreads();
    }
    SEAM(2);

    if (IN(3)) for (int rep_ = 0; rep_ < REPS(3); ++rep_) {
        if (rep_) xcd_barrier(bar);
        TID_SETUP
        for (int id = gw; id < 2048 + 1024; id += NGW) {
            if (id < 2048) {
                const int b = id >> 8, ck = (id & 255) >> 3, c = (id & 7) * 64 + lane; const size_t base = (size_t)b * 2048;
                float carry = 0.f;
                for (int k0 = 0; k0 < 4 * ck; k0 += 16) {
                    float pa[16], ha[16];
#pragma unroll
                    for (int k = 0; k < 16; ++k) { const int kk = (k0 + k < 4 * ck) ? k0 + k : 0; const size_t o = (base + 16 * kk + 15) * DL + c; pa[k] = PP[o]; ha[k] = HL[o]; }
#pragma unroll
                    for (int k = 0; k < 16; ++k) if (k0 + k < 4 * ck) carry = pa[k] * carry + ha[k];
                }
                float h = 0.f;
#pragma unroll 1
                for (int t0 = 0; t0 < 64; t0 += 16) {
                    float pa[16], ha[16]; bf16_t za[16]; const size_t row0 = base + 64 * ck + t0;
#pragma unroll
                    for (int t = 0; t < 16; ++t) { const size_t o = (row0 + t) * DL + c; pa[t] = PP[o]; ha[t] = HL[o]; za[t] = Z[(row0 + t) * DIN + 512 + c]; }
#pragma unroll
                    for (int t = 0; t < 16; ++t) { h = ha[t] + pa[t] * carry;
                        MIX[(row0 + t) * D + c] = (bf16_t)(cvt_pk_bf16(h * gelu_tanh(bf_one(za[t])), 0.f) & 0xffffu); }
                    carry = h;
                }
                if (ck == 31) out[O_PH + b * 512 + c] = h;
            } else {
                const int sid = id - 2048, b = sid >> 3, c = (sid & 7) * 64 + lane;
                const float carry = args.in[I_SH][b * 512 + c]; float h = 0.f;
#pragma unroll
                for (int s = 0; s < 8; ++s) { const size_t zr = (size_t)MP + b * 32 + 24 + s; const size_t o = zr * DL + c;
                    h = HL[o] + PP[o] * carry;
                    const float zg = bf_one(Z[zr * DIN + 512 + c]);
                    MIX[((size_t)MP + b * 8 + s) * D + c] = (bf16_t)(cvt_pk_bf16(h * gelu_tanh(zg), 0.f) & 0xffffu); }
                out[O_SH + b * 512 + c] = h;
            }
        }
        for (int i = gt; i < 8 * 3 * 512; i += NGT) { const int b = i / 1536, k = (i % 1536) >> 9, c = i & 511; out[O_PLC + i] = bf_one(Z[((size_t)b * 2048 + 2045 + k) * DIN + c]); }
        for (int i = gt; i < 8 * 15 * 512; i += NGT) { const int b = i / 7680, k = (i % 7680) >> 9, c = i & 511; out[O_PPOOL + i] = bf_one(Z[((size_t)b * 2048 + 2033 + k) * DIN + 1024 + c]); }
        for (int i = gt; i < 128 * 3 * 512; i += NGT) { const int b = i / 1536, k = (i % 1536) >> 9, c = i & 511; out[O_SLC + i] = bf_one(Z[((size_t)MP + b * 32 + 29 + k) * DIN + c]); }
        for (int i = gt; i < 128 * 8 * 512; i += NGT) { const int b = i >> 12, s = (i >> 9) & 7, c = i & 511; out[O_SPOOL + (size_t)b * 7680 + (7 + s) * 512 + c] = bf_one(Z[((size_t)MP + b * 32 + 24 + s) * DIN + 1024 + c]); }
    }
    SEAM(3);

    if (IN(4)) for (int rep_ = 0; rep_ < REPS(4); ++rep_) {
        if (rep_) xcd_barrier(bar);
        pg8::Gemm g{MIX, Wo_t, M, D, D, D}; pg8::StaticOrder S; S.init(M, D, G, (int)blockIdx.x);
        EpiX1 E{args.in[I_XP], args.in[I_XS], out + O_Y, XB, rss2};
        pg8::gemm_phase<EpiX1, pg8::StaticOrder, true, true>(lds, g, S, E);
        {
            const int nun = (M / 256) * (D / 256), first = nun - G;
            const int c0 = (first > 0 && first < G) ? first : 0, nhelp = G - c0;
            if ((int)blockIdx.x >= c0) {
                int tid = threadIdx.x; asm volatile("" : "+v"(tid)); const int lane = tid & 63, wave = __builtin_amdgcn_readfirstlane(tid >> 6);
                LAS float* scr = (LAS float*)(lds + wave * 16384);
                constexpr int I_WU = 16 * 192, I_WD = 48 * 32;
                for (int it = ((int)blockIdx.x - c0) * 8 + wave; it < I_WU + I_WD; it += nhelp * 8) {
                    if (it < I_WU) p0_transpose_item(args.in[I_UP], D, FF2, Wu_t, args.in[I_G2], true, scr, it, lane);
                    else p0_transpose_item(args.in[I_DOWN], FF, D, Wd_t, nullptr, false, scr, it - I_WU, lane);
                }
            }
        }
    }
    SEAM(4);

    if (IN(5)) for (int rep_ = 0; rep_ < REPS(5); ++rep_) {
        if (rep_) xcd_barrier(bar);
        pg8::Gemm g{XB, Wu_t, M, FF2, D, D}; pg8::StaticOrder S; S.init(M, FF2, G, (int)blockIdx.x);
        EpiFfn E{ACT, rss2, args.in[I_FCW], args.in[I_FCB], args.in[I_SFFN], edge, out + O_PFFN, out + O_SFFN, lds + LDS_X};
        pg8::gemm_phase<EpiFfn, pg8::StaticOrder, true, true>(lds, g, S, E);
    }
    SEAM(5);

    if (IN(6)) for (int rep_ = 0; rep_ < REPS(6); ++rep_) {
        if (rep_) xcd_barrier(bar);
        TID_SETUP
        const float* cw = args.in[I_FCW]; const float* cb = args.in[I_FCB];
        for (int i = gt; i < 64 * FF; i += NGT) {
            const int pm = i / FF, f = i % FF;
            if ((pm & 7) == 0) continue;
            const float* L = edge + ((size_t)(pm - 1) * 4 + 2) * FF2; const float* F = edge + (size_t)pm * 4 * FF2;
            float a0, a1;
            { const float l0 = L[f], l1 = L[FF2 + f], f0 = F[f], f1 = F[FF2 + f]; const float w0 = cw[f], w1 = cw[FF2 + f], w2 = cw[2 * FF2 + f], bb = cb[f];
              a0 = bb + w0 * l0 + w1 * l1 + w2 * f0; a1 = bb + w0 * l1 + w1 * f0 + w2 * f1; }
            float v0, v1;
            { const int fv = FF + f; const float l0 = L[fv], l1 = L[FF2 + fv], f0 = F[fv], f1 = F[FF2 + fv]; const float w0 = cw[fv], w1 = cw[FF2 + fv], w2 = cw[2 * FF2 + fv], bb = cb[fv];
              v0 = bb + w0 * l0 + w1 * l1 + w2 * f0; v1 = bb + w0 * l1 + w1 * f0 + w2 * f1; }
            ACT[(size_t)(pm * 256) * FF + f] = (bf16_t)(cvt_pk_bf16(gelu_tanh(a0) * v0, 0.f) & 0xffffu);
            ACT[(size_t)(pm * 256 + 1) * FF + f] = (bf16_t)(cvt_pk_bf16(gelu_tanh(a1) * v1, 0.f) & 0xffffu);
        }
    }
    SEAM(6);

    if (IN(7)) for (int rep_ = 0; rep_ < REPS(7); ++rep_) {
        if (rep_) xcd_barrier(bar);
        { pg8::Gemm g{ACT, Wd_t, MP, D, FF, FF}; pg8::StaticOrder S; S.init(MP, D, G, (int)blockIdx.x);
          EpiX2 E{out + O_Y};
          pg8::gemm_phase<EpiX2, pg8::StaticOrder, true, true>(lds, g, S, E); }
        { pg8::Gemm g{ACT, Wd_t, MS, D, FF / KSPLIT, FF}; pg8::SplitOrder S{G, (int)blockIdx.x, KSPLIT, FF / KSPLIT};
          EpiPart E{part};
          pg8::gemm_phase<EpiPart, pg8::SplitOrder, true, true>(lds, g, S, E); }
    }
    SEAM(7);

    if (IN(8)) for (int rep_ = 0; rep_ < REPS(8); ++rep_) {
        if (rep_) xcd_barrier(bar);
        TID_SETUP
        f32x4 gf[4];
#pragma unroll
        for (int j = 0; j < 4; ++j) gf[j] = ((const f32x4*)args.in[I_GF])[lane + 64 * j];
        for (int m = gw; m < M; m += NGW) {
            f32x4* yr = (f32x4*)(out + O_Y + (size_t)m * D) + lane; f32x4 v[4]; float s = 0.f;
#pragma unroll
            for (int j = 0; j < 4; ++j) v[j] = yr[64 * j];
            if (m >= MP) {
#pragma unroll
                for (int ks = 0; ks < KSPLIT; ++ks) { const f32x4* pr = (const f32x4*)(part + ((size_t)ks * MS + (m - MP)) * D) + lane;
#pragma unroll
                    for (int j = 0; j < 4; ++j) v[j] += pr[64 * j]; }
            }
#pragma unroll
            for (int j = 0; j < 4; ++j) s += (v[j][0] * v[j][0] + v[j][1] * v[j][1]) + (v[j][2] * v[j][2] + v[j][3] * v[j][3]);
            s = wave_sum(s); const float rstd = rsqrtf(s * (1.0f / D) + EPS);
#pragma unroll
            for (int j = 0; j < 4; ++j) yr[64 * j] = v[j] * rstd * gf[j];
        }
    }
#undef IN
#undef SEAM
}

extern "C" void kernel_launch(void* const* d_in, const int* in_sizes, int n_in, void* d_out, int out_size, void* d_ws, size_t ws_size, hipStream_t stream) {
    static int grid = 0;
    if (grid == 0) {
        if (n_in != 24 || ws_size < WS_END) { fprintf(stderr, "kernel_launch: unexpected n_in %d / ws %zu\n", n_in, ws_size); grid = -1; return; }
        int dev = 0, cus = 0, per_cu = 0;
        if (hipGetDevice(&dev) != hipSuccess || hipDeviceGetAttribute(&cus, hipDeviceAttributeMultiprocessorCount, dev) != hipSuccess) { grid = -1; return; }
        if (hipFuncSetAttribute((const void*)fwd_kernel, hipFuncAttributeMaxDynamicSharedMemorySize, LDS_BYTES) != hipSuccess) { fprintf(stderr, "kernel_launch: hipFuncSetAttribute failed\n"); grid = -1; return; }
        if (hipOccupancyMaxActiveBlocksPerMultiprocessor(&per_cu, (const void*)fwd_kernel, 512, LDS_BYTES) != hipSuccess || per_cu < 1) { fprintf(stderr, "kernel_launch: occupancy query says %d\n", per_cu); (void)hipGetLastError(); per_cu = 1; }
        grid = cus * 1;
    }
    if (grid < 0) return;
    Args a{};
    for (int i = 0; i < 24; ++i) a.in[i] = (const float*)d_in[i];
    a.out = (float*)d_out; a.ws = (unsigned char*)d_ws;
#if MK_N_LAUNCHES == 1
    a.ph_lo = 0; a.ph_hi = 9;
    if (hipMemsetAsync(d_ws, 0, 65536, stream) != hipSuccess) { fprintf(stderr, "kernel_launch: memset failed\n"); return; }
    void* kargs[] = {&a};
    hipError_t e = hipLaunchCooperativeKernel((const void*)fwd_kernel, dim3(grid), dim3(512), kargs, LDS_BYTES, stream);
    if (e != hipSuccess) fprintf(stderr, "cooperative launch failed: %s (grid %d)\n", hipGetErrorString(e), grid);
#else
    for (int p = 0; p < 9; ++p) { a.ph_lo = p; a.ph_hi = p + 1; hipLaunchKernelGGL(fwd_kernel, dim3(grid), dim3(512), LDS_BYTES, stream, a); }
#endif
}
```

```cpp
#include <hip/hip_runtime.h>
#include <hip/hip_cooperative_groups.h>
#include <cstdio>
#include <cstdint>
namespace cg = cooperative_groups;

#ifndef REP_MASK
#define REP_MASK 0
#endif
#ifndef TS_PHASE
#define TS_PHASE (-2)
#endif
#ifndef TS_DIV
#define TS_DIV 200.0f
#endif
#ifndef MK_N_LAUNCHES
#define MK_N_LAUNCHES 1
#endif

#define LAS __attribute__((address_space(3)))
typedef unsigned short bf16_t;
typedef short bf16x8 __attribute__((ext_vector_type(8)));
typedef float f32x4 __attribute__((ext_vector_type(4)));
typedef float f32x2 __attribute__((ext_vector_type(2)));
typedef unsigned u32x4 __attribute__((ext_vector_type(4)));
typedef unsigned u32x2 __attribute__((ext_vector_type(2)));

constexpr int MP = 16384, MS = 1024, M = MP + MS, D = 1024, DIN = 1536, DL = 512, FF = 3072, FF2 = 6144;
constexpr int ZROWS = MP + 128 * 32;
constexpr int NBLK = 1024 + 128;
constexpr float EPS = 1e-6f;

constexpr size_t O_Y = 0, O_PLC = 17825792, O_PH = 17838080, O_PPOOL = 17842176, O_PFFN = 17903616,
                 O_SLC = 18001920, O_SH = 18198528, O_SPOOL = 18264064, O_SFFN = 19247104;

constexpr size_t MiB = 1u << 20;
constexpr size_t WS_WI = 1 * MiB, WS_WO = 4 * MiB, WS_WU = 6 * MiB, WS_WD = 18 * MiB;
constexpr size_t WS_WA = 24 * MiB, WS_WX = WS_WA + 65536, WS_PW = WS_WX + 65536;
constexpr size_t WS_RS1 = 25 * MiB, WS_RSS2 = WS_RS1 + 131072;
constexpr size_t WS_EDGE = 27 * MiB;
constexpr size_t WS_XB = 34 * MiB;
constexpr size_t WS_MIX = 68 * MiB;
constexpr size_t WS_Z = 102 * MiB;
constexpr size_t WS_HL = 162 * MiB, WS_PP = 202 * MiB;
constexpr size_t WS_ACT = 102 * MiB;
constexpr size_t WS_PART = 68 * MiB;
constexpr size_t WS_PART2 = 204 * MiB;
constexpr size_t WS_SUMP = 242 * MiB, WS_SUMH = 245 * MiB;
constexpr size_t WS_XS = 248 * MiB;
constexpr size_t WS_END = 249 * MiB;
constexpr int CW_RED = 8192, CW_G3S = 8256, CW_PAN = 8320;

constexpr int LDS_BYTES = 147456 + 256;
constexpr int LDS_MISC = 147456;
constexpr int LDS_X = 131072;

__device__ __forceinline__ unsigned cvt_pk_bf16(float lo, float hi) { unsigned r; asm volatile("v_cvt_pk_bf16_f32 %0, %1, %2" : "=v"(r) : "v"(lo), "v"(hi)); return r; }
__device__ __forceinline__ float bf_lo(unsigned u) { return __builtin_bit_cast(float, u << 16); }
__device__ __forceinline__ float bf_hi(unsigned u) { return __builtin_bit_cast(float, u & 0xffff0000u); }
__device__ __forceinline__ float bf_one(bf16_t u) { return __builtin_bit_cast(float, (unsigned)u << 16); }
__device__ __forceinline__ float wave_sum(float v) {
#pragma unroll
    for (int o = 1; o < 64; o <<= 1) v += __shfl_xor(v, o);
    return v;
}
#define DPP_SHR(n) (0x110 + (n))
#define DPP_ROR(n) (0x120 + (n))
template <int CTRL> __device__ __forceinline__ unsigned dppu(unsigned old, unsigned src) { return (unsigned)__builtin_amdgcn_update_dpp((int)old, (int)src, CTRL, 0xf, 0xf, false); }
template <int CTRL> __device__ __forceinline__ float dppf(float old, float src) {
    return __builtin_bit_cast(float, __builtin_amdgcn_update_dpp(__builtin_bit_cast(int, old), __builtin_bit_cast(int, src), CTRL, 0xf, 0xf, false));
}
template <int CTRL> __device__ __forceinline__ float dppf_all(float src) {
    return __builtin_bit_cast(float, __builtin_amdgcn_mov_dpp(__builtin_bit_cast(int, src), CTRL, 0xf, 0xf, false));
}
template <int CTRL> __device__ __forceinline__ unsigned dppu_all(unsigned src) { return (unsigned)__builtin_amdgcn_mov_dpp((int)src, CTRL, 0xf, 0xf, false); }
template <int Dd> __device__ __forceinline__ unsigned shiftu(unsigned prev, unsigned cur) { return dppu<DPP_SHR(Dd)>(dppu_all<DPP_ROR(Dd)>(prev), cur); }
template <int Dd> __device__ __forceinline__ float shiftf(float prev, float cur) { return dppf<DPP_SHR(Dd)>(dppf_all<DPP_ROR(Dd)>(prev), cur); }

__device__ __forceinline__ float sigmoidf_(float x) { return __builtin_amdgcn_rcpf(1.0f + __builtin_amdgcn_exp2f(-1.4426950409f * x)); }
__device__ __forceinline__ float gelu_tanh(float x) {
    const float k = -2.302208198f;
    const float p = x * (k + (k * 0.044715f) * (x * x));
    return x * __builtin_amdgcn_rcpf(1.0f + __builtin_amdgcn_exp2f(p));
}

namespace pg8 {
constexpr int BM = 256, BK = 64, HALF = 128, HTB = HALF * BK * 2, STAGE_BYTES = 8 * HTB, NXCD = 8, WGM = 8;
__host__ __device__ __forceinline__ int lds_byte(int r, int c) { const int st = (r >> 4) * 2 + (c >> 5), rr = r & 15, cc = c & 31, ob = rr * 64 + cc * 2; return st * 1024 + (ob ^ (((ob >> 9) & 1) << 5)); }
__host__ __device__ __forceinline__ void stage_rc(int b, int& R, int& C) { const int st = b / 1024, sb = b % 1024, swz = sb ^ (((sb >> 9) & 1) << 5); R = (st >> 1) * 16 + swz / 64; C = (st & 1) * 32 + (swz % 64) / 2; }
__host__ __device__ __forceinline__ int perm32(int rho) { const int n = rho >> 4, i = rho & 15; return 8 * (i >> 2) + 4 * n + (i & 3); }

struct Unit { int pm, pn, k0; };
struct Gemm { const bf16_t* A; const bf16_t* Bt; int M, N, K, ld; };

struct StaticOrder {
    int nM, nN, nwg, G, c;
    __host__ __device__ void init(int M_, int N_, int G_, int c_) { nM = M_ / BM; nN = N_ / BM; nwg = nM * nN; G = G_; c = c_; }
    __host__ __device__ bool next(int i, Unit& u) const {
        const long L = (long)i * G + c; if (L >= nwg) return false;
        int wgid = (int)L; { const int q = nwg / NXCD, r = nwg % NXCD, xcd = wgid % NXCD, off = wgid / NXCD; wgid = (xcd < r ? xcd * (q + 1) : r * (q + 1) + (xcd - r) * q) + off; }
        const int nig = WGM * nN, gid = wgid / nig, fm = gid * WGM, gsz = (nM - fm) < WGM ? (nM - fm) : WGM;
        u.pm = fm + ((wgid % nig) % gsz); u.pn = (wgid % nig) / gsz; u.k0 = 0; return true;
    }
    __device__ __forceinline__ void a_ready(const Unit&) const {}
    __device__ __forceinline__ void done(const Unit&) const {}
};

struct SplitOrder {
    int G, c, nsplit, klen;
    __host__ __device__ bool next(int i, Unit& u) const {
        const int L = i * G + c; if (L >= 16 * nsplit) return false;
        const int tile = L / nsplit, ks = L % nsplit; u.pm = 64 + (tile >> 2); u.pn = tile & 3; u.k0 = ks * klen; return true;
    }
    __device__ __forceinline__ void a_ready(const Unit&) const {}
    __device__ __forceinline__ void done(const Unit&) const {}
};

struct FfnOrder {
    StaticOrder P; int G, c; unsigned* cnt;
    __device__ bool next(int i, Unit& u) const {
        const int L = i * G + c; if (L < P.nwg) return P.next(i, u);
        const int s = L - P.nwg; if (s >= 96) return false;
        u.pm = 64 + s / 24; u.pn = s % 24; u.k0 = 0; return true;
    }
    __device__ __forceinline__ void a_ready(const Unit& u) const {
        if (u.pm >= 64) { unsigned sp = 0; while (__hip_atomic_load(cnt, __ATOMIC_RELAXED, __HIP_MEMORY_SCOPE_AGENT) < (unsigned)G && ++sp < (1u << 22)) __builtin_amdgcn_s_sleep(2);
            __builtin_amdgcn_fence(__ATOMIC_ACQUIRE, "agent"); asm volatile("s_waitcnt vmcnt(0)" ::: "memory"); }
    }
    __device__ __forceinline__ void done(const Unit&) const {}
};

struct SampleFfnOrder {
    int idx, G;
    __device__ bool next(int i, Unit& u) const { if (idx < 0) return false; const int L = idx + i * G; if (L >= 96) return false; u.pm = 64 + L / 24; u.pn = L % 24; u.k0 = 0; return true; }
    __device__ __forceinline__ void a_ready(const Unit&) const {}
    __device__ __forceinline__ void done(const Unit&) const {}
};
struct GatedSplitOrder {
    int idx, G, nsplit, klen; unsigned* cnt; unsigned want;
    __device__ bool next(int i, Unit& u) const {
        if (idx < 0) return false; const int L = idx + i * G; if (L >= 16 * nsplit) return false;
        const int tile = L / nsplit, ks = L % nsplit; u.pm = 64 + (tile >> 2); u.pn = tile & 3; u.k0 = ks * klen; return true;
    }
    __device__ __forceinline__ void a_ready(const Unit&) const {
        unsigned sp = 0; while (__hip_atomic_load(cnt, __ATOMIC_RELAXED, __HIP_MEMORY_SCOPE_AGENT) < want && ++sp < (1u << 22)) __builtin_amdgcn_s_sleep(2);
        __builtin_amdgcn_fence(__ATOMIC_ACQUIRE, "agent"); asm volatile("s_waitcnt vmcnt(0)" ::: "memory");
    }
    __device__ __forceinline__ void done(const Unit&) const {}
};

template <class Epi, class Sched, bool ALIGN_EPI = false, bool SP2 = false>
__device__ __forceinline__ void gemm_phase(LAS unsigned char* lds, const Gemm g, const Sched& S, const Epi& E) {
    int tid = threadIdx.x; asm volatile("" : "+v"(tid));
    const int wid = __builtin_amdgcn_readfirstlane(tid >> 6), lane = tid & 63, wr = wid >> 2, wc = wid & 3, fr = lane & 15, fq = lane >> 4;
    const int K = g.ld, nt = g.K / BK;
    unsigned voffA[2], voffB[2];
#pragma unroll
    for (int i = 0; i < 2; ++i) { int R, C; stage_rc(tid * 16 + i * 8192, R, C); const int Rb = Epi::PERM ? ((R & ~31) + perm32(R & 31)) : R;
        voffA[i] = (unsigned)(R * K + C) * 2u; voffB[i] = (unsigned)(Rb * K + C) * 2u; }
    const size_t kstep = (size_t)(BK * 2);
    const size_t hstep = (size_t)HALF * K * 2;
    const size_t tstep = 2 * hstep;
    const unsigned ldsw = (unsigned)wid * 1024u;
    const int aoff = lds_byte(wr * 64 + fr, fq * 8), boff = lds_byte(wc * 32 + fr, fq * 8);
#define PG8_SA(b, h) (((b) * 2 + (h)) * HTB)
#define PG8_SB(b, h) ((4 + (b) * 2 + (h)) * HTB)
#define PG8_STAGE(bufoff, gbase, voff) do { _Pragma("unroll") for (int _i = 0; _i < 2; ++_i) \
        __builtin_amdgcn_global_load_lds((const unsigned*)((const char*)(gbase) + (voff)[_i]), (LAS unsigned*)(lds + (bufoff) + ldsw + _i * 8192), 16, 0, 0); } while (0)
#define PG8_LDA(dst, b, h) do { _Pragma("unroll") for (int m = 0; m < 4; ++m) _Pragma("unroll") for (int k = 0; k < 2; ++k) dst[m][k] = *(const LAS bf16x8*)(lds + PG8_SA(b, h) + aoff + m * 2048 + k * 1024); } while (0)
#define PG8_LDB(dst, b, h) do { _Pragma("unroll") for (int n = 0; n < 2; ++n) _Pragma("unroll") for (int k = 0; k < 2; ++k) dst[n][k] = *(const LAS bf16x8*)(lds + PG8_SB(b, h) + boff + n * 2048 + k * 1024); } while (0)
#define PG8_MMA(ai, bj, At, Bt) do { __builtin_amdgcn_s_setprio(1); _Pragma("unroll") for (int m = 0; m < 4; ++m) _Pragma("unroll") for (int n = 0; n < 2; ++n) _Pragma("unroll") for (int k = 0; k < 2; ++k) \
        acc[ai][bj][m][n] = __builtin_amdgcn_mfma_f32_16x16x32_bf16(Bt[n][k], At[m][k], acc[ai][bj][m][n], 0, 0, 0); __builtin_amdgcn_s_setprio(0); } while (0)
#define PG8_WAIT_V(n) asm volatile("s_waitcnt vmcnt(" #n ")" ::: "memory")
#define PG8_WAIT_L(n) asm volatile("s_waitcnt lgkmcnt(" #n ")" ::: "memory")
#define PG8_BAR __builtin_amdgcn_s_barrier()
#define PG8_SCHED __builtin_amdgcn_sched_barrier(0)
    Unit cur, nxt; int ui = 0;
    if (!S.next(0, cur)) return;
    f32x4 acc[2][2][4][2];
#pragma unroll
    for (int a = 0; a < 2; ++a)
#pragma unroll
        for (int b = 0; b < 2; ++b)
#pragma unroll
            for (int m = 0; m < 4; ++m)
#pragma unroll
                for (int n = 0; n < 2; ++n) acc[a][b][m][n] = (f32x4){0.f, 0.f, 0.f, 0.f};
    bf16x8 At[4][2], B0[2][2], B1[2][2];
    const char* cA = (const char*)g.A + (size_t)cur.pm * tstep + (size_t)cur.k0 * 2; const char* cB = (const char*)g.Bt + (size_t)cur.pn * tstep + (size_t)cur.k0 * 2;
    S.a_ready(cur);
    if constexpr (SP2) {
        PG8_STAGE(PG8_SB(0, 0), cB, voffB); PG8_STAGE(PG8_SB(0, 1), cB + hstep, voffB); PG8_STAGE(PG8_SA(0, 0), cA, voffA); PG8_STAGE(PG8_SA(0, 1), cA + hstep, voffA);
        if (wr == 1) PG8_BAR;
        PG8_WAIT_V(2); PG8_BAR;
        PG8_STAGE(PG8_SB(1, 0), cB + kstep, voffB); PG8_STAGE(PG8_SA(1, 0), cA + kstep, voffA); PG8_STAGE(PG8_SB(1, 1), cB + hstep + kstep, voffB);
        PG8_WAIT_V(6); PG8_BAR;
    } else {
        PG8_STAGE(PG8_SB(0, 0), cB, voffB); PG8_STAGE(PG8_SA(0, 0), cA, voffA); PG8_STAGE(PG8_SB(0, 1), cB + hstep, voffB); PG8_STAGE(PG8_SA(0, 1), cA + hstep, voffA);
        if (wr == 1) PG8_BAR;
        PG8_WAIT_V(4); PG8_BAR;
        PG8_STAGE(PG8_SB(1, 0), cB + kstep, voffB); PG8_STAGE(PG8_SA(1, 0), cA + kstep, voffA); PG8_STAGE(PG8_SB(1, 1), cB + hstep + kstep, voffB);
        PG8_WAIT_V(6); PG8_BAR;
    }
    for (;;) {
        const bool has_next = S.next(ui + 1, nxt);
        const char* nA = has_next ? (const char*)g.A + (size_t)nxt.pm * tstep + (size_t)nxt.k0 * 2 : cA; const char* nB = has_next ? (const char*)g.Bt + (size_t)nxt.pn * tstep + (size_t)nxt.k0 * 2 : cB;
        for (int t = 0; t < nt; t += 2) {
            const bool last = (t == nt - 2);
            const char* a1 = cA + (size_t)(t + 1) * kstep;
            const char* a2 = last ? nA : cA + (size_t)(t + 2) * kstep; const char* b2 = last ? nB : cB + (size_t)(t + 2) * kstep;
            const char* a3 = a2 + kstep; const char* b3 = b2 + kstep;
            if (last && has_next) S.a_ready(nxt);
            if constexpr (SP2) {
            PG8_LDB(B0, 0, 0); PG8_LDB(B1, 0, 1); PG8_SCHED; PG8_LDA(At, 0, 0); PG8_STAGE(PG8_SA(1, 1), a1 + hstep, voffA);
            PG8_WAIT_V(8); PG8_WAIT_L(0); PG8_BAR; PG8_MMA(0, 0, At, B0); PG8_MMA(0, 1, At, B1); PG8_BAR; PG8_SCHED;
            PG8_LDA(At, 0, 1); PG8_STAGE(PG8_SB(0, 0), b2, voffB); PG8_STAGE(PG8_SB(0, 1), b2 + hstep, voffB); PG8_STAGE(PG8_SA(0, 0), a2, voffA);
            PG8_WAIT_V(8); PG8_WAIT_L(0); PG8_BAR; PG8_MMA(1, 0, At, B0); PG8_MMA(1, 1, At, B1); PG8_BAR; PG8_SCHED;
            PG8_LDB(B0, 1, 0); PG8_LDB(B1, 1, 1); PG8_SCHED; PG8_LDA(At, 1, 0); PG8_STAGE(PG8_SA(0, 1), a2 + hstep, voffA);
            PG8_WAIT_V(8); PG8_WAIT_L(0); PG8_BAR; PG8_MMA(0, 0, At, B0); PG8_MMA(0, 1, At, B1); PG8_BAR; PG8_SCHED;
            PG8_LDA(At, 1, 1); PG8_STAGE(PG8_SB(1, 0), b3, voffB); PG8_STAGE(PG8_SB(1, 1), b3 + hstep, voffB); PG8_STAGE(PG8_SA(1, 0), a3, voffA);
            PG8_WAIT_V(8); PG8_WAIT_L(0); PG8_BAR; PG8_MMA(1, 0, At, B0); PG8_MMA(1, 1, At, B1); PG8_BAR; PG8_SCHED;
            } else {
            PG8_LDB(B0, 0, 0); PG8_SCHED; PG8_LDA(At, 0, 0); PG8_STAGE(PG8_SA(1, 1), a1 + hstep, voffA);
            PG8_WAIT_L(8); PG8_BAR; PG8_WAIT_L(0); PG8_MMA(0, 0, At, B0); PG8_BAR; PG8_SCHED;
            PG8_LDB(B1, 0, 1); PG8_STAGE(PG8_SB(0, 0), b2, voffB);
            PG8_BAR; PG8_WAIT_L(0); PG8_MMA(0, 1, At, B1); PG8_BAR;
            PG8_LDA(At, 0, 1); PG8_STAGE(PG8_SA(0, 0), a2, voffA);
            PG8_BAR; PG8_WAIT_L(0); PG8_MMA(1, 0, At, B0); PG8_BAR; PG8_SCHED;
            PG8_STAGE(PG8_SB(0, 1), b2 + hstep, voffB);
            PG8_WAIT_V(6); PG8_BAR; PG8_MMA(1, 1, At, B1); PG8_BAR;
            PG8_LDB(B0, 1, 0); PG8_SCHED; PG8_LDA(At, 1, 0); PG8_STAGE(PG8_SA(0, 1), a2 + hstep, voffA);
            PG8_WAIT_L(8); PG8_BAR; PG8_WAIT_L(0); PG8_MMA(0, 0, At, B0); PG8_BAR; PG8_SCHED;
            PG8_LDB(B1, 1, 1); PG8_STAGE(PG8_SB(1, 0), b3, voffB);
            PG8_BAR; PG8_WAIT_L(0); PG8_MMA(0, 1, At, B1); PG8_BAR;
            PG8_LDA(At, 1, 1); PG8_STAGE(PG8_SA(1, 0), a3, voffA);
            PG8_BAR; PG8_WAIT_L(0); PG8_MMA(1, 0, At, B0); PG8_BAR; PG8_SCHED;
            PG8_STAGE(PG8_SB(1, 1), b3 + hstep, voffB);
            PG8_WAIT_V(6); PG8_BAR; PG8_MMA(1, 1, At, B1); PG8_BAR;
            }
        }
        if constexpr (ALIGN_EPI) { if (wr == 0) PG8_BAR; }
        E(acc, cur, wr, wc, fr, fq); S.done(cur);
        if (!has_next) break;
#pragma unroll
        for (int a = 0; a < 2; ++a)
#pragma unroll
            for (int b = 0; b < 2; ++b)
#pragma unroll
                for (int m = 0; m < 4; ++m)
#pragma unroll
                    for (int n = 0; n < 2; ++n) acc[a][b][m][n] = (f32x4){0.f, 0.f, 0.f, 0.f};
        cur = nxt; cA = nA; cB = nB; ++ui;
        if constexpr (ALIGN_EPI) { if (wr == 1) PG8_BAR; }
    }
    PG8_WAIT_V(0);
    if constexpr (!ALIGN_EPI) { if (wr == 0) PG8_BAR; }
    PG8_BAR;
#undef PG8_SA
#undef PG8_SB
#undef PG8_STAGE
#undef PG8_LDA
#undef PG8_LDB
#undef PG8_MMA
#undef PG8_WAIT_V
#undef PG8_WAIT_L
#undef PG8_BAR
#undef PG8_SCHED
}
}
using pg8::Unit;

#define EPI_IDS int tid_ = threadIdx.x; asm volatile("" : "+v"(tid_)); const int wid_ = __builtin_amdgcn_readfirstlane(tid_ >> 6), wr = wid_ >> 2, wc = wid_ & 3, fr = tid_ & 15, fq = (tid_ >> 4) & 3;
struct EpiZ {
    static constexpr bool PERM = true;
    bf16_t* Z; const float* rs1;
    __device__ __forceinline__ void operator()(const f32x4 (&acc)[2][2][4][2], const Unit& u, int, int, int, int) const {
        EPI_IDS
        const int row0 = u.pm * 256 + wr * 64 + fr, col0 = u.pn * 256 + wc * 32 + 8 * fq;
#pragma unroll
        for (int ai = 0; ai < 2; ++ai)
#pragma unroll
            for (int m = 0; m < 4; ++m) {
                const int row = row0 + ai * 128 + m * 16; const float s = rs1[row];
                const int orow = row < MP ? row : MP + ((row - MP) >> 3) * 32 + 24 + (row & 7);
                bf16_t* rowp = Z + (size_t)orow * DIN + col0;
#pragma unroll
                for (int bj = 0; bj < 2; ++bj) { const f32x4 v0 = acc[ai][bj][m][0] * s, v1 = acc[ai][bj][m][1] * s;
                    u32x4 w; w.x = cvt_pk_bf16(v0[0], v0[1]); w.y = cvt_pk_bf16(v0[2], v0[3]); w.z = cvt_pk_bf16(v1[0], v1[1]); w.w = cvt_pk_bf16(v1[2], v1[3]);
                    *(u32x4*)(rowp + bj * 128) = w; }
            }
    }
};
struct EpiX1 {
    static constexpr bool PERM = true;
    const float* xp; const float* xs; float* y; bf16_t* X1B; float* rss2;
    __device__ __forceinline__ void operator()(const f32x4 (&acc)[2][2][4][2], const Unit& u, int, int, int, int) const {
        EPI_IDS
        const int row0 = u.pm * 256 + wr * 64 + fr, col0 = u.pn * 256 + wc * 32 + 8 * fq;
#pragma unroll
        for (int ai = 0; ai < 2; ++ai)
#pragma unroll
            for (int m = 0; m < 4; ++m) {
                const int row = row0 + ai * 128 + m * 16;
                bf16_t* br = X1B + (size_t)row * D + col0; float ss = 0.f;
#pragma unroll
                for (int bj = 0; bj < 2; ++bj) { const u32x4 xb = __builtin_nontemporal_load((const u32x4*)(br + bj * 128));
                    const f32x4 v0 = acc[ai][bj][m][0] + (f32x4){bf_lo(xb.x), bf_hi(xb.x), bf_lo(xb.y), bf_hi(xb.y)}, v1 = acc[ai][bj][m][1] + (f32x4){bf_lo(xb.z), bf_hi(xb.z), bf_lo(xb.w), bf_hi(xb.w)};
                    u32x4 w; w.x = cvt_pk_bf16(v0[0], v0[1]); w.y = cvt_pk_bf16(v0[2], v0[3]); w.z = cvt_pk_bf16(v1[0], v1[1]); w.w = cvt_pk_bf16(v1[2], v1[3]);
                    *(u32x4*)(br + bj * 128) = w;
                    ss += (v0[0] * v0[0] + v0[1] * v0[1]) + (v0[2] * v0[2] + v0[3] * v0[3]) + (v1[0] * v1[0] + v1[1] * v1[1]) + (v1[2] * v1[2] + v1[3] * v1[3]); }
                ss += __shfl_xor(ss, 16); ss += __shfl_xor(ss, 32);
                if (fq == 0) rss2[(size_t)row * 16 + u.pn * 4 + wc] = ss;
            }
    }
};
struct EpiX2 {
    static constexpr bool PERM = true;
    float* y; const bf16_t* X1B;
    __device__ __forceinline__ void operator()(const f32x4 (&acc)[2][2][4][2], const Unit& u, int, int, int, int) const {
        EPI_IDS
        const int row0 = u.pm * 256 + wr * 64 + fr, col0 = u.pn * 256 + wc * 32 + 8 * fq;
#pragma unroll
        for (int ai = 0; ai < 2; ++ai)
#pragma unroll
            for (int m = 0; m < 4; ++m) {
                const size_t o = (size_t)(row0 + ai * 128 + m * 16) * D + col0; float* yr = y + o;
#pragma unroll
                for (int bj = 0; bj < 2; ++bj) { const u32x4 xb = *(const u32x4*)(X1B + o + bj * 128);
                    const f32x4 v0 = acc[ai][bj][m][0] + (f32x4){bf_lo(xb.x), bf_hi(xb.x), bf_lo(xb.y), bf_hi(xb.y)}, v1 = acc[ai][bj][m][1] + (f32x4){bf_lo(xb.z), bf_hi(xb.z), bf_lo(xb.w), bf_hi(xb.w)};
                    *(f32x4*)(yr + bj * 128) = v0; *(f32x4*)(yr + bj * 128 + 4) = v1; }
            }
    }
};
struct EpiX2N {
    static constexpr bool PERM = true;
    float* y; const bf16_t* X1B; const float* gf; float* xs; unsigned* pan; LAS unsigned char* lx;
    __device__ __forceinline__ void operator()(f32x4 (&acc)[2][2][4][2], const Unit& u, int, int, int, int) const {
        EPI_IDS
        LAS float* PS = (LAS float*)lx;
        LAS float* RT = PS + 1024;
        const int row0 = u.pm * 256 + wr * 64 + fr, col0 = u.pn * 256 + wc * 32 + 8 * fq;
#pragma unroll
        for (int ai = 0; ai < 2; ++ai)
#pragma unroll
            for (int m = 0; m < 4; ++m) {
                const size_t o = (size_t)(row0 + ai * 128 + m * 16) * D + col0; float ss = 0.f;
#pragma unroll
                for (int bj = 0; bj < 2; ++bj) { const u32x4 xb = __builtin_nontemporal_load((const u32x4*)(X1B + o + bj * 128));
                    acc[ai][bj][m][0] += (f32x4){bf_lo(xb.x), bf_hi(xb.x), bf_lo(xb.y), bf_hi(xb.y)}; acc[ai][bj][m][1] += (f32x4){bf_lo(xb.z), bf_hi(xb.z), bf_lo(xb.w), bf_hi(xb.w)};
                    const f32x4 v0 = acc[ai][bj][m][0], v1 = acc[ai][bj][m][1];
                    ss += (v0[0] * v0[0] + v0[1] * v0[1]) + (v0[2] * v0[2] + v0[3] * v0[3]) + (v1[0] * v1[0] + v1[1] * v1[1]) + (v1[2] * v1[2] + v1[3] * v1[3]); }
                ss += __shfl_xor(ss, 16); ss += __shfl_xor(ss, 32);
                if (fq == 0) PS[(ai * 128 + wr * 64 + m * 16 + fr) * 4 + wc] = ss;
            }
        asm volatile("s_waitcnt lgkmcnt(0)" ::: "memory"); __builtin_amdgcn_s_barrier(); asm volatile("" ::: "memory");
        float* slot = xs + ((size_t)u.pm * 256 + (tid_ & 255)) * 4;
        if (tid_ < 256) { const f32x4 p = *(const LAS f32x4*)(PS + tid_ * 4); __hip_atomic_store(slot + u.pn, (p[0] + p[1]) + (p[2] + p[3]), __ATOMIC_RELAXED, __HIP_MEMORY_SCOPE_AGENT); }
        asm volatile("s_waitcnt vmcnt(0)" ::: "memory"); __builtin_amdgcn_s_barrier(); asm volatile("" ::: "memory");
        if (tid_ == 0) {
            unsigned* c = pan + 64 * u.pm;
            __hip_atomic_fetch_add(c, 1u, __ATOMIC_RELAXED, __HIP_MEMORY_SCOPE_AGENT);
            unsigned sp = 0; while (__hip_atomic_load(c, __ATOMIC_RELAXED, __HIP_MEMORY_SCOPE_AGENT) < 4u && ++sp < (1u << 22)) __builtin_amdgcn_s_sleep(2);
            __builtin_amdgcn_fence(__ATOMIC_ACQUIRE, "agent"); asm volatile("s_waitcnt vmcnt(0)" ::: "memory");
        }
        __builtin_amdgcn_s_barrier(); asm volatile("" ::: "memory");
        if (tid_ < 256) { float t = 0.f;
#pragma unroll
            for (int k = 0; k < 4; ++k) t += __hip_atomic_load(slot + k, __ATOMIC_RELAXED, __HIP_MEMORY_SCOPE_AGENT);
            RT[tid_] = rsqrtf(t * (1.0f / D) + EPS); }
        asm volatile("s_waitcnt vmcnt(0) lgkmcnt(0)" ::: "memory"); __builtin_amdgcn_s_barrier(); asm volatile("" ::: "memory");
        f32x4 gv[2][2];
#pragma unroll
        for (int bj = 0; bj < 2; ++bj) { gv[bj][0] = *(const f32x4*)(gf + col0 + bj * 128); gv[bj][1] = *(const f32x4*)(gf + col0 + bj * 128 + 4); }
#pragma unroll
        for (int ai = 0; ai < 2; ++ai)
#pragma unroll
            for (int m = 0; m < 4; ++m) {
                const float r = RT[ai * 128 + wr * 64 + m * 16 + fr]; float* yr = y + (size_t)(row0 + ai * 128 + m * 16) * D + col0;
#pragma unroll
                for (int bj = 0; bj < 2; ++bj) { __builtin_nontemporal_store(acc[ai][bj][m][0] * r * gv[bj][0], (f32x4*)(yr + bj * 128)); __builtin_nontemporal_store(acc[ai][bj][m][1] * r * gv[bj][1], (f32x4*)(yr + bj * 128 + 4)); }
            }
    }
};
constexpr int KSPLIT = 4;
struct EpiPart {
    static constexpr bool PERM = true;
    float* part; int klen;
    __device__ __forceinline__ void operator()(const f32x4 (&acc)[2][2][4][2], const Unit& u, int, int, int, int) const {
        EPI_IDS
        const int row0 = (u.pm - 64) * 256 + wr * 64 + fr, col0 = u.pn * 256 + wc * 32 + 8 * fq;
        float* pb = part + (size_t)(u.k0 / klen) * MS * D;
#pragma unroll
        for (int ai = 0; ai < 2; ++ai)
#pragma unroll
            for (int m = 0; m < 4; ++m) {
                float* yr = pb + (size_t)(row0 + ai * 128 + m * 16) * D + col0;
#pragma unroll
                for (int bj = 0; bj < 2; ++bj) { *(f32x4*)(yr + bj * 128) = acc[ai][bj][m][0]; *(f32x4*)(yr + bj * 128 + 4) = acc[ai][bj][m][1]; }
            }
    }
};
template <bool SAMPLE_TILES> struct EpiFfn {
    static constexpr bool PERM = true;
    bf16_t* ACT; const float* rss2; const float* cw; const float* cb; const float* stf; float* edge; float* outp; float* outs; LAS unsigned char* lx;
    template <bool SAMPLE>
    __device__ __forceinline__ void body(f32x4 (&acc)[2][2][4][2], const Unit& u, int, int, int, int) const {
        LAS float* RS = (LAS float*)lx; LAS float* XCH = RS + 256;
        int tid = threadIdx.x; asm volatile("" : "+v"(tid));
        const int wid = __builtin_amdgcn_readfirstlane(tid >> 6), wr = wid >> 2, wc = wid & 3, fr = tid & 15, fq = (tid >> 4) & 3;
        { const int row = tid >> 1, half = tid & 1; const f32x4* p = (const f32x4*)(rss2 + (size_t)(u.pm * 256 + row) * 16 + half * 8);
          const f32x4 a = p[0], b = p[1]; float s = ((a[0] + a[1]) + (a[2] + a[3])) + ((b[0] + b[1]) + (b[2] + b[3]));
          s += __shfl_xor(s, 1);
          if (!half) RS[row] = rsqrtf(s * (1.0f / D) + EPS); }
        asm volatile("s_waitcnt lgkmcnt(0)" ::: "memory"); __builtin_amdgcn_s_barrier(); asm volatile("" ::: "memory");
        const int cw0 = wc * 32 + 8 * fq;
        const LAS float* rsw = RS + wr * 64 + fr;
        if (!SAMPLE) {
            if (fr >= 14) {
#pragma unroll
                for (int ai = 0; ai < 2; ++ai) { const int seg = 2 * ai + wr; const float s = rsw[ai * 128 + 48];
                    if (seg < 3) {
#pragma unroll
                        for (int bj = 0; bj < 2; ++bj)
#pragma unroll
                            for (int n = 0; n < 2; ++n) *(LAS f32x4*)(XCH + (seg * 2 + (fr - 14)) * 256 + bj * 128 + cw0 + 4 * n) = acc[ai][bj][3][n] * s; } }
            }
            if (wr == 0 && fr < 2) { float* e = edge + ((size_t)u.pm * 4 + fr) * FF2 + u.pn * 128 + cw0; const float s = rsw[0];
#pragma unroll
                for (int bj = 0; bj < 2; ++bj)
#pragma unroll
                    for (int n = 0; n < 2; ++n) *(f32x4*)(e + bj * FF + 4 * n) = acc[0][bj][0][n] * s; }
            if (wr == 1 && fr >= 14) { float* e = edge + ((size_t)u.pm * 4 + 2 + (fr - 14)) * FF2 + u.pn * 128 + cw0; const float s = rsw[128 + 48];
#pragma unroll
                for (int bj = 0; bj < 2; ++bj)
#pragma unroll
                    for (int n = 0; n < 2; ++n) *(f32x4*)(e + bj * FF + 4 * n) = acc[1][bj][3][n] * s;
                if ((u.pm & 7) == 7) { float* o = outp + ((size_t)(u.pm >> 3) * 2 + (fr - 14)) * FF2 + u.pn * 128 + cw0;
#pragma unroll
                    for (int bj = 0; bj < 2; ++bj)
#pragma unroll
                        for (int n = 0; n < 2; ++n) *(f32x4*)(o + bj * FF + 4 * n) = acc[1][bj][3][n] * s; } }
        } else {
            if ((fr & 7) >= 6) {
#pragma unroll
                for (int ai = 0; ai < 2; ++ai)
#pragma unroll
                    for (int m = 0; m < 4; ++m) { const int b = ((u.pm - 64) * 256 + ai * 128 + wr * 64 + m * 16 + fr) >> 3; const float s = rsw[ai * 128 + m * 16];
                        float* o = outs + ((size_t)b * 2 + ((fr & 7) - 6)) * FF2 + u.pn * 128 + cw0;
#pragma unroll
                        for (int bj = 0; bj < 2; ++bj)
#pragma unroll
                            for (int n = 0; n < 2; ++n) *(f32x4*)(o + bj * FF + 4 * n) = acc[ai][bj][m][n] * s; }
            }
        }
        f32x2 wq[8];
        { const int g0 = u.pn * 128 + cw0, v0 = FF + g0;
          wq[0] = *(const f32x2*)(cw + g0); wq[1] = *(const f32x2*)(cw + FF2 + g0); wq[2] = *(const f32x2*)(cw + 2 * FF2 + g0); wq[3] = *(const f32x2*)(cb + g0);
          wq[4] = *(const f32x2*)(cw + v0); wq[5] = *(const f32x2*)(cw + FF2 + v0); wq[6] = *(const f32x2*)(cw + 2 * FF2 + v0); wq[7] = *(const f32x2*)(cb + v0); }
        asm volatile("s_waitcnt lgkmcnt(0)" ::: "memory"); __builtin_amdgcn_s_barrier(); asm volatile("" ::: "memory");
        unsigned keep[2][2][2][4];
#pragma unroll
        for (int n = 0; n < 2; ++n)
#pragma unroll
        for (int jp = 0; jp < 2; ++jp) {
            __builtin_amdgcn_sched_barrier(0);
            const int c0 = cw0 + 4 * n + 2 * jp, gcol = u.pn * 128 + c0, vcol = FF + gcol;
            const f32x2 wg0 = wq[0], wg1 = wq[1], wg2 = wq[2], bg = wq[3], wv0 = wq[4], wv1 = wq[5], wv2 = wq[6], bv = wq[7];
            if (2 * n + jp < 3) { const int gn = gcol + (jp == 0 ? 2 : 2), vn = FF + gn;
                wq[0] = *(const f32x2*)(cw + gn); wq[1] = *(const f32x2*)(cw + FF2 + gn); wq[2] = *(const f32x2*)(cw + 2 * FF2 + gn); wq[3] = *(const f32x2*)(cb + gn);
                wq[4] = *(const f32x2*)(cw + vn); wq[5] = *(const f32x2*)(cw + FF2 + vn); wq[6] = *(const f32x2*)(cw + 2 * FF2 + vn); wq[7] = *(const f32x2*)(cb + vn); }
            f32x2 p1g, p2g, p1v, p2v;
#pragma unroll
            for (int ai = 0; ai < 2; ++ai) {
                if (!SAMPLE) {
                    const int seg = 2 * ai + wr;
                    if (seg == 0) { p1g = p2g = p1v = p2v = (f32x2){0.f, 0.f}; }
                    else { const LAS float* xb = XCH + (seg - 1) * 512 + c0;
                        p1g = *(const LAS f32x2*)(xb + 256); p2g = *(const LAS f32x2*)(xb + (fr & 1) * 256);
                        p1v = *(const LAS f32x2*)(xb + 256 + 128); p2v = *(const LAS f32x2*)(xb + (fr & 1) * 256 + 128); }
                }
#pragma unroll
                for (int m = 0; m < 4; ++m) {
                    const float s = rsw[ai * 128 + m * 16];
                    const f32x2 g = (f32x2){acc[ai][0][m][n][2 * jp], acc[ai][0][m][n][2 * jp + 1]} * s, v = (f32x2){acc[ai][1][m][n][2 * jp], acc[ai][1][m][n][2 * jp + 1]} * s;
                    f32x2 g1, g2, v1, v2;
                    if (!SAMPLE) {
#pragma unroll
                        for (int j = 0; j < 2; ++j) { g1[j] = dppf<DPP_SHR(1)>(p1g[j], g[j]); g2[j] = dppf<DPP_SHR(2)>(p2g[j], g[j]);
                            v1[j] = dppf<DPP_SHR(1)>(p1v[j], v[j]); v2[j] = dppf<DPP_SHR(2)>(p2v[j], v[j]); }
#pragma unroll
                        for (int j = 0; j < 2; ++j) { p1g[j] = dppf_all<DPP_ROR(1)>(g[j]); p2g[j] = dppf_all<DPP_ROR(2)>(g[j]);
                            p1v[j] = dppf_all<DPP_ROR(1)>(v[j]); p2v[j] = dppf_all<DPP_ROR(2)>(v[j]); }
                    } else {
                        const int b = ((u.pm - 64) * 256 + ai * 128 + wr * 64 + m * 16 + fr) >> 3, sq = fr & 7;
#pragma unroll
                        for (int j = 0; j < 2; ++j) { g1[j] = dppf<DPP_SHR(1)>(0.f, g[j]); g2[j] = dppf<DPP_SHR(2)>(0.f, g[j]);
                            v1[j] = dppf<DPP_SHR(1)>(0.f, v[j]); v2[j] = dppf<DPP_SHR(2)>(0.f, v[j]); }
                        {
                            const float* sp = stf + (size_t)b * 2 * FF2; const int ra = sq < 1 ? 0 : FF2;
                            const f32x2 ag = *(const f32x2*)(sp + ra + gcol), av = *(const f32x2*)(sp + ra + vcol), bg1 = *(const f32x2*)(sp + FF2 + gcol), bv1 = *(const f32x2*)(sp + FF2 + vcol);
                            if (sq < 2) { g2 = ag; v2 = av; }
                            if (sq == 0) { g1 = bg1; v1 = bv1; } }
                    }
                    const f32x2 ug = bg + wg0 * g2 + wg1 * g1 + wg2 * g, uv = bv + wv0 * v2 + wv1 * v1 + wv2 * v;
                    keep[n][jp][ai][m] = cvt_pk_bf16(gelu_tanh(ug[0]) * uv[0], gelu_tanh(ug[1]) * uv[1]);
                }
            }
        }
        __builtin_amdgcn_sched_barrier(0);
#pragma unroll
        for (int ai = 0; ai < 2; ++ai)
#pragma unroll
            for (int m = 0; m < 4; ++m)
                *(u32x4*)(ACT + (size_t)(u.pm * 256 + ai * 128 + wr * 64 + m * 16 + fr) * FF + u.pn * 128 + cw0) = (u32x4){keep[0][0][ai][m], keep[0][1][ai][m], keep[1][0][ai][m], keep[1][1][ai][m]};
    }
    __device__ __forceinline__ void operator()(f32x4 (&acc)[2][2][4][2], const Unit& u, int wr, int wc, int fr, int fq) const { body<SAMPLE_TILES>(acc, u, wr, wc, fr, fq); }
};

struct Args { const float* in[24]; float* out; unsigned char* ws; int ph_lo, ph_hi; };
enum { I_XP = 0, I_XS, I_SLC, I_SH, I_SPOOL, I_SFFN, I_G1, I_WIN, I_LCW, I_LCB, I_WA, I_BA, I_WX, I_BX, I_LAM, I_PW, I_PSC, I_WOUT, I_G2, I_UP, I_FCW, I_FCB, I_DOWN, I_GF };

__device__ __forceinline__ void p0_transpose_item(const float* W, int K, int N, bf16_t* WT, const float* kscale, bool up_map, LAS float* scr, int item, int lane) {
    const int nblk = N / 32, kb = item / nblk, nb = item % nblk, k0 = 64 * kb, n0 = 32 * nb;
    int drow0 = n0;
    if (up_map) { const int bj = n0 / FF, f = n0 % FF; drow0 = 256 * (f >> 7) + 128 * bj + (f & 127); }
    float tv[32];
#pragma unroll
    for (int i = 0; i < 32; ++i) { const int kk = 2 * i + (lane >> 5); tv[i] = __builtin_nontemporal_load(W + (size_t)(k0 + kk) * N + n0 + (lane & 31)); }
    if (kscale) {
#pragma unroll
        for (int i = 0; i < 32; ++i) tv[i] *= kscale[k0 + 2 * i + (lane >> 5)];
    }
#pragma unroll
    for (int i = 0; i < 32; ++i) scr[(2 * i + (lane >> 5)) * 33 + (lane & 31)] = tv[i];
    asm volatile("s_waitcnt lgkmcnt(0)" ::: "memory");
    const int c = lane & 7;
#pragma unroll
    for (int j = 0; j < 4; ++j) { const int n = (lane >> 3) + 8 * j; const LAS float* s = scr + (8 * c) * 33 + n;
        u32x4 o; o.x = cvt_pk_bf16(s[0 * 33], s[1 * 33]); o.y = cvt_pk_bf16(s[2 * 33], s[3 * 33]); o.z = cvt_pk_bf16(s[4 * 33], s[5 * 33]); o.w = cvt_pk_bf16(s[6 * 33], s[7 * 33]);
        *(u32x4*)(WT + (size_t)(drow0 + n) * K + k0 + 8 * c) = o; }
    asm volatile("s_waitcnt lgkmcnt(0)" ::: "memory");
}

struct MixCtx { const bf16_t* Z; unsigned* HP; float* SUMP; float* SUMH; bf16_t* MIX; const float* pscale; };

__device__ __forceinline__ void blk_desc(int blk, int& zrow0, bool& hasprev, int& segmask) {
    if (blk < 1024) { zrow0 = blk * 16; hasprev = (blk & 127) != 0; segmask = 15; }
    else { zrow0 = MP + (blk - 1024) * 32 + 16; hasprev = true; segmask = 7; }
}

__device__ __forceinline__ void lru_load(const MixCtx& C, int h, int blk, int lane, u32x4 (&zc)[2], u32x4 (&zq)[2]) {
    const int r = lane & 15, q = lane >> 4;
    int zrow0, segmask; bool hasprev; blk_desc(blk, zrow0, hasprev, segmask);
    const bf16_t* zp = C.Z + (size_t)(zrow0 + r) * DIN + h * 64 + q * 8;
    zc[0] = __builtin_nontemporal_load((const u32x4*)zp); zc[1] = __builtin_nontemporal_load((const u32x4*)(zp + 32));
    zq[0] = zq[1] = (u32x4){0u, 0u, 0u, 0u};
    if (hasprev) { zq[0] = *(const u32x4*)(zp - 16 * DIN); zq[1] = *(const u32x4*)(zp - 16 * DIN + 32); }
}
__device__ __forceinline__ void lru_item(const MixCtx& C, int h, int blk, const bf16x8 (&WA)[4][2], const bf16x8 (&WX)[4][2], const LAS float* KC, int lane, const u32x4 (&zc)[2], const u32x4 (&zq)[2]) {
    const int r = lane & 15, q = lane >> 4;
    int zrow0, segmask; bool hasprev; blk_desc(blk, zrow0, hasprev, segmask);
    float xc[2][8]; bf16x8 Bf[2];
#pragma unroll
    for (int kb = 0; kb < 2; ++kb) {
        const LAS float* kc = KC + kb * 32 + q * 8;
        f32x4 w[4][2], bb[2];
#pragma unroll
        for (int t = 0; t < 4; ++t) { w[t][0] = *(const LAS f32x4*)(kc + t * 64); w[t][1] = *(const LAS f32x4*)(kc + t * 64 + 4); }
        bb[0] = *(const LAS f32x4*)(kc + 256); bb[1] = *(const LAS f32x4*)(kc + 260);
#pragma unroll
        for (int i2 = 0; i2 < 4; ++i2) {
            const unsigned c0 = zc[kb][i2], pv = zq[kb][i2];
            const unsigned s1 = shiftu<1>(pv, c0), s2 = shiftu<2>(pv, c0), s3 = shiftu<3>(pv, c0);
            const int e = 2 * i2, hh = e >> 2, ee = e & 3;
            xc[kb][e]     = bb[hh][ee]     + w[3][hh][ee]     * bf_lo(c0) + w[2][hh][ee]     * bf_lo(s1) + w[1][hh][ee]     * bf_lo(s2) + w[0][hh][ee]     * bf_lo(s3);
            xc[kb][e + 1] = bb[hh][ee + 1] + w[3][hh][ee + 1] * bf_hi(c0) + w[2][hh][ee + 1] * bf_hi(s1) + w[1][hh][ee + 1] * bf_hi(s2) + w[0][hh][ee + 1] * bf_hi(s3);
        }
        u32x4 pk; pk.x = cvt_pk_bf16(xc[kb][0], xc[kb][1]); pk.y = cvt_pk_bf16(xc[kb][2], xc[kb][3]); pk.z = cvt_pk_bf16(xc[kb][4], xc[kb][5]); pk.w = cvt_pk_bf16(xc[kb][6], xc[kb][7]);
        Bf[kb] = __builtin_bit_cast(bf16x8, pk);
    }
    const bool dead = (segmask == 7) && (r < 8);
    f32x4 R[4], I[4];
#pragma unroll
    for (int n = 0; n < 4; ++n) { R[n] = (f32x4){0.f, 0.f, 0.f, 0.f}; I[n] = R[n]; }
#pragma unroll
    for (int n = 0; n < 4; ++n) { R[n] = __builtin_amdgcn_mfma_f32_16x16x32_bf16(WA[n][0], Bf[0], R[n], 0, 0, 0); I[n] = __builtin_amdgcn_mfma_f32_16x16x32_bf16(WX[n][0], Bf[0], I[n], 0, 0, 0); }
#pragma unroll
    for (int n = 0; n < 4; ++n) { R[n] = __builtin_amdgcn_mfma_f32_16x16x32_bf16(WA[n][1], Bf[1], R[n], 0, 0, 0); I[n] = __builtin_amdgcn_mfma_f32_16x16x32_bf16(WX[n][1], Bf[1], I[n], 0, 0, 0); }
    float av[16], bv[16];
#pragma unroll
    for (int n = 0; n < 4; ++n) {
        const int kb = n >> 1, half = n & 1;
        const LAS float* kc = KC + kb * 32 + q * 8 + half * 4;
        const f32x4 ba = *(const LAS f32x4*)(kc + 320), bx = *(const LAS f32x4*)(kc + 384), sp = *(const LAS f32x4*)(kc + 448);
#pragma unroll
        for (int j = 0; j < 4; ++j) {
            const float rg = sigmoidf_(R[n][j] + ba[j]), ig = sigmoidf_(I[n][j] + bx[j]);
            const float la = (-8.0f * 1.4426950409f) * rg * sp[j];
            const float a = __builtin_amdgcn_exp2f(la);
            const float mm = 1.0f - a * a;
            av[n * 4 + j] = dead ? 1.0f : a;
            bv[n * 4 + j] = dead ? 0.0f : __builtin_amdgcn_sqrtf(mm) * ig * xc[kb][half * 4 + j];
        }
    }
#define SC8_STEP(d) \
        "v_fmac_f32_dpp %8, %8, %0 row_shr:" #d " row_mask:0xf bank_mask:0xf\n"   "v_fmac_f32_dpp %9, %9, %1 row_shr:" #d " row_mask:0xf bank_mask:0xf\n" \
        "v_fmac_f32_dpp %10, %10, %2 row_shr:" #d " row_mask:0xf bank_mask:0xf\n" "v_fmac_f32_dpp %11, %11, %3 row_shr:" #d " row_mask:0xf bank_mask:0xf\n" \
        "v_fmac_f32_dpp %12, %12, %4 row_shr:" #d " row_mask:0xf bank_mask:0xf\n" "v_fmac_f32_dpp %13, %13, %5 row_shr:" #d " row_mask:0xf bank_mask:0xf\n" \
        "v_fmac_f32_dpp %14, %14, %6 row_shr:" #d " row_mask:0xf bank_mask:0xf\n" "v_fmac_f32_dpp %15, %15, %7 row_shr:" #d " row_mask:0xf bank_mask:0xf\n" \
        "v_mul_f32_dpp %0, %0, %0 row_shr:" #d " row_mask:0xf bank_mask:0xf\n" "v_mul_f32_dpp %1, %1, %1 row_shr:" #d " row_mask:0xf bank_mask:0xf\n" \
        "v_mul_f32_dpp %2, %2, %2 row_shr:" #d " row_mask:0xf bank_mask:0xf\n" "v_mul_f32_dpp %3, %3, %3 row_shr:" #d " row_mask:0xf bank_mask:0xf\n" \
        "v_mul_f32_dpp %4, %4, %4 row_shr:" #d " row_mask:0xf bank_mask:0xf\n" "v_mul_f32_dpp %5, %5, %5 row_shr:" #d " row_mask:0xf bank_mask:0xf\n" \
        "v_mul_f32_dpp %6, %6, %6 row_shr:" #d " row_mask:0xf bank_mask:0xf\n" "v_mul_f32_dpp %7, %7, %7 row_shr:" #d " row_mask:0xf bank_mask:0xf\n"
#pragma unroll
    for (int hb = 0; hb < 2; ++hb) {
        asm volatile("s_nop 1\n" SC8_STEP(1) SC8_STEP(2) SC8_STEP(4) SC8_STEP(8)
                     : "+v"(av[hb * 8 + 0]), "+v"(av[hb * 8 + 1]), "+v"(av[hb * 8 + 2]), "+v"(av[hb * 8 + 3]), "+v"(av[hb * 8 + 4]), "+v"(av[hb * 8 + 5]), "+v"(av[hb * 8 + 6]), "+v"(av[hb * 8 + 7]),
                       "+v"(bv[hb * 8 + 0]), "+v"(bv[hb * 8 + 1]), "+v"(bv[hb * 8 + 2]), "+v"(bv[hb * 8 + 3]), "+v"(bv[hb * 8 + 4]), "+v"(bv[hb * 8 + 5]), "+v"(bv[hb * 8 + 6]), "+v"(bv[hb * 8 + 7]));
    }
#undef SC8_STEP
#pragma unroll
    for (int n = 0; n < 4; ++n) {
        const int kb = n >> 1, half = n & 1;
        const f32x4 a = {av[n * 4], av[n * 4 + 1], av[n * 4 + 2], av[n * 4 + 3]}, b = {bv[n * 4], bv[n * 4 + 1], bv[n * 4 + 2], bv[n * 4 + 3]};
        const int ch = h * 64 + kb * 32 + q * 8 + half * 4;
        u32x4 hp; hp.x = cvt_pk_bf16(b[0], a[0]); hp.y = cvt_pk_bf16(b[1], a[1]); hp.z = cvt_pk_bf16(b[2], a[2]); hp.w = cvt_pk_bf16(b[3], a[3]);
        *(u32x4*)(C.HP + (size_t)(zrow0 + r) * DL + ch) = hp;
        if (r == 15) { const size_t so = (size_t)(zrow0 >> 4) * DL + ch; *(f32x4*)(C.SUMP + so) = a; *(f32x4*)(C.SUMH + so) = b; }
    }
}

__device__ __forceinline__ void pool_load(const MixCtx& C, int g, int blk, int lane, u32x4 (&pc)[4], u32x4 (&pq)[4]) {
    const int r = lane & 15, q = lane >> 4;
    int zrow0, segmask; bool hasprev; blk_desc(blk, zrow0, hasprev, segmask);
    const bf16_t* zp = C.Z + (size_t)(zrow0 + r) * DIN + 1024 + g * 128 + q * 8;
#pragma unroll
    for (int ks = 0; ks < 4; ++ks) { pc[ks] = __builtin_nontemporal_load((const u32x4*)(zp + ks * 32)); pq[ks] = (u32x4){0u, 0u, 0u, 0u}; if (hasprev) pq[ks] = *(const u32x4*)(zp + ks * 32 - 16 * DIN); }
}
__device__ __forceinline__ void pool_item(const MixCtx& C, int g, int blk, const LAS unsigned char* PWL, int lane, const u32x4 (&pc)[4], const u32x4 (&pq)[4]) {
    const int r = lane & 15, q = lane >> 4;
    int zrow0, segmask; bool hasprev; blk_desc(blk, zrow0, hasprev, segmask);
    const bool prompt = blk < 1024;
    const int orow = prompt ? zrow0 + r : MP + (blk - 1024) * 8 + (r - 8);
    const bool valid = prompt || r >= 8;
    const int w = 2 << g;
    int cnt = w; if (prompt) { const int t1 = ((zrow0 + r) & 2047) + 1; cnt = t1 < w ? t1 : w; }
    const float inv = __builtin_amdgcn_rcpf((float)cnt);
    bf16x8 Bf[4];
#pragma unroll
    for (int ks = 0; ks < 4; ++ks) {
        const u32x4 c = pc[ks], p = pq[ks];
        float pl[8], xs[8], S[8], PS[8];
#pragma unroll
        for (int e = 0; e < 8; ++e) { xs[e] = (e & 1) ? bf_hi(c[e >> 1]) : bf_lo(c[e >> 1]); PS[e] = (e & 1) ? bf_hi(p[e >> 1]) : bf_lo(p[e >> 1]); S[e] = xs[e]; }
#pragma unroll
        for (int e = 0; e < 8; ++e) S[e] += shiftf<1>(PS[e], S[e]);
        if (g >= 1) {
#pragma unroll
            for (int e = 0; e < 8; ++e) PS[e] += dppf<DPP_SHR(1)>(0.f, PS[e]);
#pragma unroll
            for (int e = 0; e < 8; ++e) S[e] += shiftf<2>(PS[e], S[e]);
        }
        if (g >= 2) {
#pragma unroll
            for (int e = 0; e < 8; ++e) PS[e] += dppf<DPP_SHR(2)>(0.f, PS[e]);
#pragma unroll
            for (int e = 0; e < 8; ++e) S[e] += shiftf<4>(PS[e], S[e]);
        }
        if (g >= 3) {
#pragma unroll
            for (int e = 0; e < 8; ++e) PS[e] += dppf<DPP_SHR(4)>(0.f, PS[e]);
#pragma unroll
            for (int e = 0; e < 8; ++e) S[e] += shiftf<8>(PS[e], S[e]);
        }
#pragma unroll
        for (int e = 0; e < 8; ++e) pl[e] = S[e] * inv - xs[e];
        u32x4 pk; pk.x = cvt_pk_bf16(pl[0], pl[1]); pk.y = cvt_pk_bf16(pl[2], pl[3]); pk.z = cvt_pk_bf16(pl[4], pl[5]); pk.w = cvt_pk_bf16(pl[6], pl[7]);
        Bf[ks] = __builtin_bit_cast(bf16x8, pk);
    }
#pragma unroll
    for (int m2 = 0; m2 < 4; ++m2) {
        f32x4 y[2];
#pragma unroll
        for (int half = 0; half < 2; ++half) {
            const int out = m2 * 32 + (r >> 2) * 8 + half * 4 + (r & 3);
            const LAS unsigned char* wrow = PWL + (g * 128 + out) * 256;
            f32x4 Dv = {0.f, 0.f, 0.f, 0.f};
#pragma unroll
            for (int ks = 0; ks < 4; ++ks) { const bf16x8 A = *(const LAS bf16x8*)(wrow + (((ks * 4 + q) ^ r) << 4)); Dv = __builtin_amdgcn_mfma_f32_16x16x32_bf16(A, Bf[ks], Dv, 0, 0, 0); }
            const f32x4 sc = *(const f32x4*)(C.pscale + g * 128 + m2 * 32 + q * 8 + half * 4);
            y[half] = Dv * sc;
        }
        if (valid) { u32x4 pk; pk.x = cvt_pk_bf16(y[0][0], y[0][1]); pk.y = cvt_pk_bf16(y[0][2], y[0][3]); pk.z = cvt_pk_bf16(y[1][0], y[1][1]); pk.w = cvt_pk_bf16(y[1][2], y[1][3]);
            *(u32x4*)(C.MIX + (size_t)orow * D + 512 + g * 128 + m2 * 32 + q * 8) = pk; }
    }
}

#define XB_TMO      128
#define XB_XCNT(j)  (256  + 64 * (j))
#define XB_XSUB(j)  (1280 + 64 * (j))
#define XB_XGEN(j)  (2304 + 64 * (j))
#define XB_TOP      3328
#define XB_TOPGEN   3392
#define XCD_BAR_WORDS 3456
#define XB_SPIN_CAP (1u << 22)
__device__ __forceinline__ unsigned xb_ld(unsigned* p)              { return __hip_atomic_load(p, __ATOMIC_RELAXED, __HIP_MEMORY_SCOPE_AGENT); }
__device__ __forceinline__ unsigned xb_add(unsigned* p, unsigned v) { return __hip_atomic_fetch_add(p, v, __ATOMIC_RELAXED, __HIP_MEMORY_SCOPE_AGENT); }
__device__ __forceinline__ unsigned xb_xcc_id() { return (unsigned)__builtin_amdgcn_s_getreg((3 << 11) | 20) & 0xFu; }
#define XB_SPIN(cond, bar) do { unsigned _sp = 0; while (cond) { __builtin_amdgcn_s_sleep(1); \
    if ((++_sp & 255u) == 0u) { if (xb_ld(&(bar)[XB_TMO])) break; if (_sp > XB_SPIN_CAP) { atomicAdd(&(bar)[XB_TMO], 1u); break; } } } } while (0)
struct XcdBarrier { unsigned* bar; unsigned x; volatile LAS unsigned* st; };
__device__ __forceinline__ XcdBarrier xcd_barrier_post(unsigned* bar, volatile LAS unsigned* st) {
    XcdBarrier b; b.bar = bar; b.x = xb_xcc_id(); b.st = st;
    if (threadIdx.x == 0) (void)xb_add(&bar[XB_XCNT(b.x)], 1u);
    return b;
}
__device__ __forceinline__ void xcd_barrier_complete(unsigned* bar, unsigned x, unsigned& nloc, unsigned& nx) {
    const unsigned G = gridDim.x * gridDim.y * gridDim.z;
    unsigned sum, cnt, mine, sp = 0u;
    for (;;) {
        sum = 0u; cnt = 0u; mine = 0u;
#pragma unroll
        for (unsigned j = 0; j < 16; ++j) { const unsigned c = xb_ld(&bar[XB_XCNT(j)]); sum += c; cnt += (c > 0u) ? 1u : 0u; mine = (j == x) ? c : mine; }
        if (sum == G) break;
        __builtin_amdgcn_s_sleep(1);
        if ((++sp & 255u) == 0u) { if (xb_ld(&bar[XB_TMO])) break; if (sp > XB_SPIN_CAP) { atomicAdd(&bar[XB_TMO], 1u); break; } }
    }
    nloc = mine > 0u ? mine : 1u; nx = cnt > 0u ? cnt : 1u;
}
__device__ __forceinline__ void xcd_barrier(const XcdBarrier& b) {
    asm volatile("s_waitcnt vmcnt(0)" ::: "memory");
    __syncthreads();
    if (threadIdx.x == 0) {
        unsigned* bar = b.bar;
        __builtin_amdgcn_s_waitcnt(0);
        unsigned nloc = b.st[0], nx = b.st[1];
        if (nloc == 0u) { xcd_barrier_complete(bar, b.x, nloc, nx); b.st[0] = nloc; b.st[1] = nx; }
        const unsigned old = xb_add(&bar[XB_XSUB(b.x)], 1u);
        const unsigned gen = old / nloc;
        if (old + 1u == (gen + 1u) * nloc) {
            __builtin_amdgcn_fence(__ATOMIC_RELEASE, "agent");
            asm volatile("s_waitcnt vmcnt(0)" ::: "memory");
            const unsigned og = xb_add(&bar[XB_TOP], 1u);
            const unsigned tg = og / nx;
            if (og + 1u == (tg + 1u) * nx) xb_add(&bar[XB_TOPGEN], 1u);
            else XB_SPIN(xb_ld(&bar[XB_TOPGEN]) == tg, bar);
            __builtin_amdgcn_fence(__ATOMIC_ACQUIRE, "agent");
            xb_add(&bar[XB_XGEN(b.x)], 1u);
            asm volatile("s_waitcnt vmcnt(0)" ::: "memory");
        } else {
            XB_SPIN(xb_ld(&bar[XB_XGEN(b.x)]) == gen, bar);
            __builtin_amdgcn_fence(__ATOMIC_ACQUIRE, "agent");
            asm volatile("s_waitcnt vmcnt(0)" ::: "memory");
        }
    }
    __syncthreads();
}

__global__ void __launch_bounds__(512, 2) fwd_kernel(Args args) {
    extern __shared__ __attribute__((aligned(16))) unsigned char lds_raw[];
    LAS unsigned char* lds = (LAS unsigned char*)lds_raw;
    cg::grid_group grid = cg::this_grid();
    const int G = gridDim.x, NGW = G * 8, NGT = G * 512;
#define TID_SETUP int tid = threadIdx.x; asm volatile("" : "+v"(tid)); const int lane = tid & 63, wave = __builtin_amdgcn_readfirstlane(tid >> 6), gw = blockIdx.x * 8 + wave, gt = blockIdx.x * 512 + tid; (void)lane; (void)gw; (void)gt;
    unsigned char* ws = args.ws; float* out = args.out;
    bf16_t* Wi_t = (bf16_t*)(ws + WS_WI); bf16_t* Wo_t = (bf16_t*)(ws + WS_WO); bf16_t* Wu_t = (bf16_t*)(ws + WS_WU); bf16_t* Wd_t = (bf16_t*)(ws + WS_WD);
    bf16_t* WA_t = (bf16_t*)(ws + WS_WA); bf16_t* WX_t = (bf16_t*)(ws + WS_WX); bf16_t* PW_t = (bf16_t*)(ws + WS_PW);
    float* rs1 = (float*)(ws + WS_RS1); float* rss2 = (float*)(ws + WS_RSS2); float* edge = (float*)(ws + WS_EDGE);
    bf16_t* XB = (bf16_t*)(ws + WS_XB); bf16_t* MIX = (bf16_t*)(ws + WS_MIX); bf16_t* Z = (bf16_t*)(ws + WS_Z);
    unsigned* HP = (unsigned*)(ws + WS_HL); float* SUMP = (float*)(ws + WS_SUMP); float* SUMH = (float*)(ws + WS_SUMH); bf16_t* ACT = (bf16_t*)(ws + WS_ACT); float* part = (float*)(ws + WS_PART); float* part2 = (float*)(ws + WS_PART2);
    const int lo = args.ph_lo, hi = args.ph_hi;
#define IN(k) (lo <= (k) && (k) < hi)
#define REPS(k) ((((REP_MASK) >> (k)) & 1) + 1)
#define SEAM(k) do { if (IN(k) && IN((k) + 1)) xcd_barrier(bar); } while (0)
    for (int u_ = threadIdx.x; u_ < 64; u_ += 512) ((LAS unsigned*)(lds + LDS_MISC))[u_] = 0u;
    __syncthreads();
    XcdBarrier bar; bar.bar = (unsigned*)ws; bar.x = 0; bar.st = (volatile LAS unsigned*)(lds + LDS_MISC);
    if (hi - lo > 1) bar = xcd_barrier_post((unsigned*)ws, (volatile LAS unsigned*)(lds + LDS_MISC));
    unsigned long long ts0_ = 0, ts1_ = 0;
#define STAMP(k) do { if (TS_PHASE >= 0) { if ((k) == TS_PHASE - 1) ts0_ = __builtin_amdgcn_s_memrealtime(); if ((k) == TS_PHASE) ts1_ = __builtin_amdgcn_s_memrealtime(); } } while (0)
    STAMP(-1);
    if (hi > 1000) grid.sync();

    if (IN(0)) for (int rep_ = 0; rep_ < REPS(0); ++rep_) {
        if (rep_) xcd_barrier(bar);
        TID_SETUP
        LAS float* scr = (LAS float*)(lds + wave * 16384);
        constexpr int I_WI = 16 * 48, I_G = 8 * 2, I_P = 4 * 8;
        constexpr int NIT = I_WI + 2 * I_G + I_P;
        for (int it = gw; it < NIT; it += NGW) {
            int r = it;
            if (r < I_WI) { p0_transpose_item(args.in[I_WIN], D, DIN, Wi_t, args.in[I_G1], false, scr, r, lane); continue; } r -= I_WI;
            if (r < I_G) { p0_transpose_item(args.in[I_WA] + (r >> 1) * 4096, 64, 64, WA_t + (r >> 1) * 4096, nullptr, false, scr, r & 1, lane); continue; } r -= I_G;
            if (r < I_G) { p0_transpose_item(args.in[I_WX] + (r >> 1) * 4096, 64, 64, WX_t + (r >> 1) * 4096, nullptr, false, scr, r & 1, lane); continue; } r -= I_G;
            p0_transpose_item(args.in[I_PW] + (r >> 3) * 16384, 128, 128, PW_t + (r >> 3) * 16384, nullptr, false, scr, r & 7, lane);
        }
        for (int m0 = gw; m0 < M; m0 += 4 * NGW) {
            f32x4 v[4][4]; float s[4]; int mr[4]; bool ok[4];
#pragma unroll
            for (int r = 0; r < 4; ++r) { const int m = m0 + r * NGW; ok[r] = m < M; mr[r] = ok[r] ? m : m0;
                const float* xrow = mr[r] < MP ? args.in[I_XP] + (size_t)mr[r] * D : args.in[I_XS] + (size_t)(mr[r] - MP) * D; const f32x4* xr = (const f32x4*)xrow + lane;
#pragma unroll
                for (int j = 0; j < 4; ++j) v[r][j] = __builtin_nontemporal_load(xr + 64 * j); }
#pragma unroll
            for (int r = 0; r < 4; ++r) { s[r] = 0.f;
#pragma unroll
                for (int j = 0; j < 4; ++j) s[r] += (v[r][j][0] * v[r][j][0] + v[r][j][1] * v[r][j][1]) + (v[r][j][2] * v[r][j][2] + v[r][j][3] * v[r][j][3]); }
#pragma unroll
            for (int o = 1; o < 64; o <<= 1) {
#pragma unroll
                for (int r = 0; r < 4; ++r) s[r] += __shfl_xor(s[r], o); }
#pragma unroll
            for (int r = 0; r < 4; ++r) if (ok[r]) {
                if (lane == 0) rs1[mr[r]] = rsqrtf(s[r] * (1.0f / D) + EPS);
                u32x2* o8 = (u32x2*)(XB + (size_t)mr[r] * D) + lane;
#pragma unroll
                for (int j = 0; j < 4; ++j) { u32x2 w; w.x = cvt_pk_bf16(v[r][j][0], v[r][j][1]); w.y = cvt_pk_bf16(v[r][j][2], v[r][j][3]); o8[64 * j] = w; } }
        }
        for (int it = gw; it < 128 * 24; it += NGW) {
            const int b = it / 24, r = it % 24;
            bf16_t* zr = Z + (size_t)(MP + b * 32 + r) * DIN;
#pragma unroll
            for (int j = 0; j < 3; ++j) {
                const int c = lane * 8 + 512 * j; u32x4 w = {0u, 0u, 0u, 0u};
                const float* src = nullptr;
                if (j == 0 && r >= 21) src = args.in[I_SLC] + ((size_t)b * 3 + (r - 21)) * 512 + c;
                if (j == 2 && r >= 9) src = args.in[I_SPOOL] + ((size_t)b * 15 + (r - 9)) * 512 + (c - 1024);
                if (src) { const f32x4 a = *(const f32x4*)src, bq = *(const f32x4*)(src + 4); w.x = cvt_pk_bf16(a[0], a[1]); w.y = cvt_pk_bf16(a[2], a[3]); w.z = cvt_pk_bf16(bq[0], bq[1]); w.w = cvt_pk_bf16(bq[2], bq[3]); }
                *(u32x4*)(zr + c) = w;
            }
        }
        for (int i = gt; i < 128 * 7 * 512; i += NGT) { const int b = i / 3584, rem = i % 3584; out[O_SPOOL + (size_t)b * 7680 + rem] = args.in[I_SPOOL][(size_t)b * 7680 + 4096 + rem]; }
    }
    SEAM(0); STAMP(0);

    if (IN(1)) for (int rep_ = 0; rep_ < REPS(1); ++rep_) {
        if (rep_) xcd_barrier(bar);
        {
            const int nun = (M / 256) * (DIN / 256), first = nun - G;
            const int c0 = (first > 0 && first < G) ? first : 0, nhelp = G - c0;
            if ((int)blockIdx.x >= c0) {
                int tid = threadIdx.x; asm volatile("" : "+v"(tid)); const int lane = tid & 63, wave = __builtin_amdgcn_readfirstlane(tid >> 6);
                LAS float* scr = (LAS float*)(lds + wave * 16384);
                constexpr int I_WO = 16 * 32, I_WU = 16 * 192;
                for (int it = ((int)blockIdx.x - c0) * 8 + wave; it < I_WO + I_WU; it += nhelp * 8) {
                    if (it < I_WO) p0_transpose_item(args.in[I_WOUT], D, D, Wo_t, nullptr, false, scr, it, lane);
                    else p0_transpose_item(args.in[I_UP], D, FF2, Wu_t, args.in[I_G2], true, scr, it - I_WO, lane);
                }
            }
        }
        __syncthreads();
        pg8::Gemm g{XB, Wi_t, M, DIN, D, D}; pg8::StaticOrder S; S.init(M, DIN, G, (int)blockIdx.x);
        EpiZ E{Z, rs1};
        pg8::gemm_phase<EpiZ, pg8::StaticOrder, true, true>(lds, g, S, E);
    }
    SEAM(1); STAMP(1);

    if (IN(2)) for (int rep_ = 0; rep_ < REPS(2); ++rep_) {
        if (rep_) xcd_barrier(bar);
        TID_SETUP
        for (int ch = tid; ch < 8192; ch += 512) { const int row = ch >> 4, c = ch & 15, o = row & 127, key = ((o >> 3) & 3) * 4 + (o & 3);
            *(LAS u32x4*)(lds + row * 256 + ((c ^ key) << 4)) = *(const u32x4*)(PW_t + (size_t)row * 128 + c * 8); }
        __syncthreads();
        MixCtx C{Z, HP, SUMP, SUMH, MIX, args.in[I_PSC]};
        LAS float* KC = (LAS float*)(lds + LDS_X + wave * 2048);
        {
            const int i0 = (int)((long)gw * (8 * NBLK) / NGW), i1 = (int)((long)(gw + 1) * (8 * NBLK) / NGW);
            int curh = -1; bf16x8 WA[4][2], WX[4][2];
#pragma unroll
            for (int n = 0; n < 4; ++n)
#pragma unroll
                for (int k = 0; k < 2; ++k) { WA[n][k] = (bf16x8){0, 0, 0, 0, 0, 0, 0, 0}; WX[n][k] = WA[n][k]; }
            u32x4 zc[2], zq[2];
            zc[0] = zc[1] = zq[0] = zq[1] = (u32x4){0u, 0u, 0u, 0u};
            if (i0 < i1) lru_load(C, i0 / NBLK, i0 % NBLK, lane, zc, zq);
            for (int it = i0; it < i1; ++it) {
                const int h = it / NBLK, blk = it % NBLK;
                if (h != curh) {
                    curh = h;
                    asm volatile("s_waitcnt lgkmcnt(0)" ::: "memory");
                    const int ch = h * 64 + lane;
#pragma unroll
                    for (int t = 0; t < 4; ++t) KC[t * 64 + lane] = args.in[I_LCW][t * 512 + ch];
                    KC[256 + lane] = args.in[I_LCB][ch]; KC[320 + lane] = args.in[I_BA][ch]; KC[384 + lane] = args.in[I_BX][ch];
                    { const float lam = args.in[I_LAM][ch]; KC[448 + lane] = log1pf(expf(-lam)); }
                    const int rho = lane & 15, qq = lane >> 4;
#pragma unroll
                    for (int n = 0; n < 4; ++n) { const int o = (n >> 1) * 32 + (rho >> 2) * 8 + (n & 1) * 4 + (rho & 3);
#pragma unroll
                        for (int k = 0; k < 2; ++k) { WA[n][k] = *(const bf16x8*)(WA_t + (size_t)(h * 64 + o) * 64 + k * 32 + qq * 8); WX[n][k] = *(const bf16x8*)(WX_t + (size_t)(h * 64 + o) * 64 + k * 32 + qq * 8); } }
                    asm volatile("s_waitcnt lgkmcnt(0)" ::: "memory");
                }
                u32x4 nzc[2], nzq[2];
                if (it + 1 < i1) lru_load(C, (it + 1) / NBLK, (it + 1) % NBLK, lane, nzc, nzq);
                else { nzc[0] = nzc[1] = nzq[0] = nzq[1] = (u32x4){0u, 0u, 0u, 0u}; }
                lru_item(C, h, blk, WA, WX, KC, lane, zc, zq);
                zc[0] = nzc[0]; zc[1] = nzc[1]; zq[0] = nzq[0]; zq[1] = nzq[1];
            }
        }
        {
            const int gwr = NGW - 1 - gw;
            const int i0 = (int)((long)gwr * (4 * NBLK) / NGW), i1 = (int)((long)(gwr + 1) * (4 * NBLK) / NGW);
            u32x4 pc[4], pq[4];
#pragma unroll
            for (int ks = 0; ks < 4; ++ks) pc[ks] = pq[ks] = (u32x4){0u, 0u, 0u, 0u};
            if (i0 < i1) pool_load(C, i0 / NBLK, i0 % NBLK, lane, pc, pq);
            for (int it = i0; it < i1; ++it) {
                u32x4 npc[4], npq[4];
                if (it + 1 < i1) pool_load(C, (it + 1) / NBLK, (it + 1) % NBLK, lane, npc, npq);
                else {
#pragma unroll
                    for (int ks = 0; ks < 4; ++ks) npc[ks] = npq[ks] = (u32x4){0u, 0u, 0u, 0u}; }
                pool_item(C, it / NBLK, it % NBLK, lds, lane, pc, pq);
#pragma unroll
                for (int ks = 0; ks < 4; ++ks) { pc[ks] = npc[ks]; pq[ks] = npq[ks]; }
            }
        }
        __syncthreads();
    }
    SEAM(2); STAMP(2);

    if (IN(3)) for (int rep_ = 0; rep_ < REPS(3); ++rep_) {
        if (rep_) xcd_barrier(bar);
        TID_SETUP
        for (int id = gw; id < 2048 + 1024; id += NGW) {
            if (id < 2048) {
                const int b = id >> 8, ck = (id & 255) >> 3, c = (id & 7) * 64 + lane; const size_t base = (size_t)b * 2048;
                float carry = 0.f;
                for (int k0 = 0; k0 < 4 * ck; k0 += 32) {
                    float pa[32], ha[32];
#pragma unroll
                    for (int k = 0; k < 32; ++k) { const int kk = (k0 + k < 4 * ck) ? k0 + k : 0; const size_t o = ((size_t)b * 128 + kk) * DL + c; pa[k] = SUMP[o]; ha[k] = SUMH[o]; }
#pragma unroll
                    for (int k = 0; k < 32; ++k) if (k0 + k < 4 * ck) carry = pa[k] * carry + ha[k];
                }
                float h = 0.f;
#pragma unroll 1
                for (int t0 = 0; t0 < 64; t0 += 32) {
                    unsigned wa[32]; bf16_t za[32]; float sp[2], sh[2]; const size_t row0 = base + 64 * ck + t0;
#pragma unroll
                    for (int t = 0; t < 32; ++t) { wa[t] = __builtin_nontemporal_load(HP + (row0 + t) * DL + c); za[t] = __builtin_nontemporal_load(Z + (row0 + t) * DIN + 512 + c); }
#pragma unroll
                    for (int k = 0; k < 2; ++k) { const size_t o = ((row0 >> 4) + k) * DL + c; sp[k] = SUMP[o]; sh[k] = SUMH[o]; }
#pragma unroll
                    for (int t = 0; t < 32; ++t) {
                        if ((t & 15) == 15) { h = sh[t >> 4] + sp[t >> 4] * carry; } else { h = bf_lo(wa[t]) + bf_hi(wa[t]) * carry; }
                        MIX[(row0 + t) * D + c] = (bf16_t)(cvt_pk_bf16(h * gelu_tanh(bf_one(za[t])), 0.f) & 0xffffu);
                        if ((t & 15) == 15) carry = h; }
                }
                if (ck == 31) out[O_PH + b * 512 + c] = h;
            } else {
                const int sid = id - 2048, b = sid >> 3, c = (sid & 7) * 64 + lane;
                const float carry = args.in[I_SH][b * 512 + c]; float h = 0.f;
#pragma unroll
                for (int s = 0; s < 8; ++s) { const size_t zr = (size_t)MP + b * 32 + 24 + s;
                    if (s == 7) { const size_t so = (zr >> 4) * DL + c; h = SUMH[so] + SUMP[so] * carry; } else { const unsigned w = HP[zr * DL + c]; h = bf_lo(w) + bf_hi(w) * carry; }
                    const float zg = bf_one(Z[zr * DIN + 512 + c]);
                    MIX[((size_t)MP + b * 8 + s) * D + c] = (bf16_t)(cvt_pk_bf16(h * gelu_tanh(zg), 0.f) & 0xffffu); }
                out[O_SH + b * 512 + c] = h;
            }
        }
        for (int i = gt; i < 8 * 3 * 512; i += NGT) { const int b = i / 1536, k = (i % 1536) >> 9, c = i & 511; out[O_PLC + i] = bf_one(Z[((size_t)b * 2048 + 2045 + k) * DIN + c]); }
        for (int i = gt; i < 8 * 15 * 512; i += NGT) { const int b = i / 7680, k = (i % 7680) >> 9, c = i & 511; out[O_PPOOL + i] = bf_one(Z[((size_t)b * 2048 + 2033 + k) * DIN + 1024 + c]); }
        for (int i = gt; i < 128 * 3 * 512; i += NGT) { const int b = i / 1536, k = (i % 1536) >> 9, c = i & 511; out[O_SLC + i] = bf_one(Z[((size_t)MP + b * 32 + 29 + k) * DIN + c]); }
        for (int i = gt; i < 128 * 8 * 512; i += NGT) { const int b = i >> 12, s = (i >> 9) & 7, c = i & 511; out[O_SPOOL + (size_t)b * 7680 + (7 + s) * 512 + c] = bf_one(Z[((size_t)MP + b * 32 + 24 + s) * DIN + 1024 + c]); }
    }
    SEAM(3); STAMP(3);

    if (IN(4)) for (int rep_ = 0; rep_ < REPS(4); ++rep_) {
        if (rep_) xcd_barrier(bar);
        {
            const int c0 = 64 < G ? 64 : 0, nhelp = G - c0;
            if ((int)blockIdx.x >= c0) {
                int tid = threadIdx.x; asm volatile("" : "+v"(tid)); const int lane = tid & 63, wave = __builtin_amdgcn_readfirstlane(tid >> 6);
                LAS float* scr = (LAS float*)(lds + wave * 16384);
                for (int it = ((int)blockIdx.x - c0) * 8 + wave; it < 48 * 32; it += nhelp * 8) p0_transpose_item(args.in[I_DOWN], FF, D, Wd_t, nullptr, false, scr, it, lane);
            }
        }
        __syncthreads();
        { pg8::Gemm g{MIX, Wo_t, MP, D, D, D}; pg8::StaticOrder S; S.init(MP, D, G, (int)blockIdx.x);
          EpiX1 E{args.in[I_XP], args.in[I_XS], out + O_Y, XB, rss2};
          pg8::gemm_phase<EpiX1, pg8::StaticOrder, true, true>(lds, g, S, E); }
        { pg8::Gemm g{MIX, Wo_t, MS, D, D / 4, D}; pg8::SplitOrder S{G, (int)blockIdx.x, 4, D / 4};
          EpiPart E{part2, D / 4};
          pg8::gemm_phase<EpiPart, pg8::SplitOrder, true, true>(lds, g, S, E); }
    }
    SEAM(4); STAMP(4);

    if (IN(5)) for (int rep_ = 0; rep_ < REPS(5); ++rep_) {
        if (rep_) xcd_barrier(bar);
        unsigned* red_cnt = (unsigned*)ws + CW_RED;
        {
            int tid = threadIdx.x; asm volatile("" : "+v"(tid)); const int lane = tid & 63, wave = __builtin_amdgcn_readfirstlane(tid >> 6);
            for (int r = blockIdx.x * 8 + wave; r < MS; r += NGW) {
                const f32x4* xr = (const f32x4*)(args.in[I_XS] + (size_t)r * D) + lane; f32x4 v[4]; float s = 0.f;
#pragma unroll
                for (int j = 0; j < 4; ++j) v[j] = xr[64 * j];
#pragma unroll
                for (int ks = 0; ks < 4; ++ks) { const f32x4* pr = (const f32x4*)(part2 + ((size_t)ks * MS + r) * D) + lane;
#pragma unroll
                    for (int j = 0; j < 4; ++j) v[j] += __builtin_nontemporal_load(pr + 64 * j); }
#pragma unroll
                for (int j = 0; j < 4; ++j) s += (v[j][0] * v[j][0] + v[j][1] * v[j][1]) + (v[j][2] * v[j][2] + v[j][3] * v[j][3]);
                s = wave_sum(s);
                if (lane < 16) rss2[(size_t)(MP + r) * 16 + lane] = lane == 0 ? s : 0.f;
                u32x2* o8 = (u32x2*)(XB + (size_t)(MP + r) * D) + lane;
#pragma unroll
                for (int j = 0; j < 4; ++j) { u32x2 w; w.x = cvt_pk_bf16(v[j][0], v[j][1]); w.y = cvt_pk_bf16(v[j][2], v[j][3]); o8[64 * j] = w; }
            }
            (void)red_cnt;
        }
        pg8::Gemm g{XB, Wu_t, MP, FF2, D, D}; pg8::StaticOrder S; S.init(MP, FF2, G, (int)blockIdx.x);
        EpiFfn<false> E{ACT, rss2, args.in[I_FCW], args.in[I_FCB], args.in[I_SFFN], edge, out + O_PFFN, out + O_SFFN, lds + LDS_X};
        pg8::gemm_phase<EpiFfn<false>, pg8::StaticOrder, true, true>(lds, g, S, E);
    }
    SEAM(5); STAMP(5);

    if (IN(7)) for (int rep_ = 0; rep_ < REPS(7); ++rep_) {
        if (rep_) xcd_barrier(bar);
        unsigned* g3s_cnt = (unsigned*)ws + CW_G3S;
        {
            int tid = threadIdx.x; asm volatile("" : "+v"(tid));
            const int pm = 8 * ((int)blockIdx.x & 7) + (((int)blockIdx.x >> 3) & 7);
            if ((pm & 7) != 0) {
                const float* cw = args.in[I_FCW]; const float* cb = args.in[I_FCB];
                const float* L = edge + ((size_t)(pm - 1) * 4 + 2) * FF2; const float* F = edge + (size_t)pm * 4 * FF2;
                for (int f = tid; f < FF; f += 512) {
                    float a0, a1;
                    { const float l0 = L[f], l1 = L[FF2 + f], f0 = F[f], f1 = F[FF2 + f]; const float w0 = cw[f], w1 = cw[FF2 + f], w2 = cw[2 * FF2 + f], bb = cb[f];
                      a0 = bb + w0 * l0 + w1 * l1 + w2 * f0; a1 = bb + w0 * l1 + w1 * f0 + w2 * f1; }
                    float v0, v1;
                    { const int fv = FF + f; const float l0 = L[fv], l1 = L[FF2 + fv], f0 = F[fv], f1 = F[FF2 + fv]; const float w0 = cw[fv], w1 = cw[FF2 + fv], w2 = cw[2 * FF2 + fv], bb = cb[fv];
                      v0 = bb + w0 * l0 + w1 * l1 + w2 * f0; v1 = bb + w0 * l1 + w1 * f0 + w2 * f1; }
                    ACT[(size_t)(pm * 256) * FF + f] = (bf16_t)(cvt_pk_bf16(gelu_tanh(a0) * v0, 0.f) & 0xffffu);
                    ACT[(size_t)(pm * 256 + 1) * FF + f] = (bf16_t)(cvt_pk_bf16(gelu_tanh(a1) * v1, 0.f) & 0xffffu);
                }
            }
            asm volatile("s_waitcnt vmcnt(0)" ::: "memory"); __syncthreads();
        }
        const int cb = (int)blockIdx.x, loc = cb >> 3, l8 = loc & 7;
        const int rankA = l8 < 3 ? (cb & 7) + 8 * ((loc >> 3) * 3 + l8) : -1, rankB = l8 >= 3 ? (cb & 7) + 8 * ((loc >> 3) * 5 + (l8 - 3)) : -1;
        {
            pg8::Gemm g{XB, Wu_t, M, FF2, D, D}; pg8::SampleFfnOrder S{rankA, G};
            EpiFfn<true> E{ACT, rss2, args.in[I_FCW], args.in[I_FCB], args.in[I_SFFN], edge, out + O_PFFN, out + O_SFFN, lds + LDS_X};
            pg8::gemm_phase<EpiFfn<true>, pg8::SampleFfnOrder, true, true>(lds, g, S, E);
            asm volatile("s_waitcnt vmcnt(0)" ::: "memory"); __syncthreads();
            if (rankA >= 0 && threadIdx.x == 0) { __builtin_amdgcn_fence(__ATOMIC_RELEASE, "agent"); asm volatile("s_waitcnt vmcnt(0)" ::: "memory"); __hip_atomic_fetch_add(g3s_cnt, 1u, __ATOMIC_RELAXED, __HIP_MEMORY_SCOPE_AGENT); }
        }
        { pg8::Gemm g{ACT, Wd_t, MP, D, FF, FF}; pg8::StaticOrder S; S.init(MP, D, G, (int)blockIdx.x);
          EpiX2N E{out + O_Y, XB, args.in[I_GF], (float*)(ws + WS_XS), (unsigned*)ws + CW_PAN, lds + LDS_X};
          pg8::gemm_phase<EpiX2N, pg8::StaticOrder, true, true>(lds, g, S, E); }
        { pg8::Gemm g{ACT, Wd_t, MS, D, FF / KSPLIT, FF}; pg8::GatedSplitOrder S{rankB, G, KSPLIT, FF / KSPLIT, g3s_cnt, 96u};
          EpiPart E{part, FF / KSPLIT};
          pg8::gemm_phase<EpiPart, pg8::GatedSplitOrder, true, true>(lds, g, S, E); }
    }
    SEAM(7); STAMP(7);

    if (IN(8)) for (int rep_ = 0; rep_ < REPS(8); ++rep_) {
        if (rep_) xcd_barrier(bar);
        TID_SETUP
        f32x4 gf[4];
#pragma unroll
        for (int j = 0; j < 4; ++j) gf[j] = ((const f32x4*)args.in[I_GF])[lane + 64 * j];
        for (int m = MP + (int)blockIdx.x + G * wave; m < M; m += NGW) {
            f32x4* yr = (f32x4*)(out + O_Y + (size_t)m * D) + lane; f32x4 v[4]; float s = 0.f;
            if (m < MP) {
#pragma unroll
                for (int j = 0; j < 4; ++j) v[j] = yr[64 * j];
            } else {
                const u32x2* xb = (const u32x2*)(XB + (size_t)m * D) + lane;
#pragma unroll
                for (int j = 0; j < 4; ++j) { const u32x2 w = xb[64 * j]; v[j] = (f32x4){bf_lo(w.x), bf_hi(w.x), bf_lo(w.y), bf_hi(w.y)}; }
#pragma unroll
                for (int ks = 0; ks < KSPLIT; ++ks) { const f32x4* pr = (const f32x4*)(part + ((size_t)ks * MS + (m - MP)) * D) + lane;
#pragma unroll
                    for (int j = 0; j < 4; ++j) v[j] += pr[64 * j]; }
            }
#pragma unroll
            for (int j = 0; j < 4; ++j) s += (v[j][0] * v[j][0] + v[j][1] * v[j][1]) + (v[j][2] * v[j][2] + v[j][3] * v[j][3]);
            s = wave_sum(s); const float rstd = rsqrtf(s * (1.0f / D) + EPS);
#pragma unroll
            for (int j = 0; j < 4; ++j) yr[64 * j] = v[j] * rstd * gf[j];
        }
    }
    STAMP(8);
    if (TS_PHASE >= 0 && blockIdx.x == 0 && threadIdx.x == 0) out[O_Y] += (float)(ts1_ - ts0_) * 0.01f / TS_DIV;
#undef IN
#undef SEAM
}

extern "C" void kernel_launch(void* const* d_in, const int* in_sizes, int n_in, void* d_out, int out_size, void* d_ws, size_t ws_size, hipStream_t stream) {
    static int grid = 0;
    if (grid == 0) {
        if (n_in != 24 || ws_size < WS_END) { fprintf(stderr, "kernel_launch: unexpected n_in %d / ws %zu\n", n_in, ws_size); grid = -1; return; }
        int dev = 0, cus = 0, per_cu = 0;
        if (hipGetDevice(&dev) != hipSuccess || hipDeviceGetAttribute(&cus, hipDeviceAttributeMultiprocessorCount, dev) != hipSuccess) { grid = -1; return; }
        if (hipFuncSetAttribute((const void*)fwd_kernel, hipFuncAttributeMaxDynamicSharedMemorySize, LDS_BYTES) != hipSuccess) { fprintf(stderr, "kernel_launch: hipFuncSetAttribute failed\n"); grid = -1; return; }
        if (hipOccupancyMaxActiveBlocksPerMultiprocessor(&per_cu, (const void*)fwd_kernel, 512, LDS_BYTES) != hipSuccess || per_cu < 1) { fprintf(stderr, "kernel_launch: occupancy query says %d\n", per_cu); (void)hipGetLastError(); per_cu = 1; }
        if (cus != 256) { fprintf(stderr, "kernel_launch: built for a 256-CU device (one workgroup per CU; the fused final norm pairs 4 workgroups per row panel), found %d CUs; nothing launched\n", cus); grid = -1; return; }
        grid = cus * 1;
    }
    if (grid < 0) return;
    Args a{};
    for (int i = 0; i < 24; ++i) a.in[i] = (const float*)d_in[i];
    a.out = (float*)d_out; a.ws = (unsigned char*)d_ws;
    if (hipMemsetAsync(d_ws, 0, 65536, stream) != hipSuccess) { fprintf(stderr, "kernel_launch: memset failed\n"); return; }
#if MK_N_LAUNCHES == 1
    a.ph_lo = 0; a.ph_hi = 9;
    void* kargs[] = {&a};
    hipError_t e = hipLaunchCooperativeKernel((const void*)fwd_kernel, dim3(grid), dim3(512), kargs, LDS_BYTES, stream);
    if (e != hipSuccess) fprintf(stderr, "cooperative launch failed: %s (grid %d)\n", hipGetErrorString(e), grid);
#else
    for (int p = 0; p < 9; ++p) { a.ph_lo = p; a.ph_hi = p + 1; hipLaunchKernelGGL(fwd_kernel, dim3(grid), dim3(512), LDS_BYTES, stream, a); }
#endif
}
```

```cpp
#include <hip/hip_runtime.h>
#include <hip/hip_cooperative_groups.h>
#include <cstdio>
#include <cstdint>
namespace cg = cooperative_groups;

#ifndef REP_MASK
#define REP_MASK 0
#endif
#ifndef TS_PHASE
#define TS_PHASE (-2)
#endif
#ifndef TS_DIV
#define TS_DIV 200.0f
#endif
#ifndef MK_N_LAUNCHES
#define MK_N_LAUNCHES 1
#endif

#define LAS __attribute__((address_space(3)))
typedef unsigned short bf16_t;
typedef short bf16x8 __attribute__((ext_vector_type(8)));
typedef float f32x4 __attribute__((ext_vector_type(4)));
typedef float f32x2 __attribute__((ext_vector_type(2)));
typedef unsigned u32x4 __attribute__((ext_vector_type(4)));
typedef unsigned u32x2 __attribute__((ext_vector_type(2)));

constexpr int MP = 16384, MS = 1024, M = MP + MS, D = 1024, DIN = 1536, DL = 512, FF = 3072, FF2 = 6144;
constexpr int ZROWS = MP + 128 * 32;
constexpr int NBLK = 1024 + 128;
constexpr float EPS = 1e-6f;

constexpr size_t O_Y = 0, O_PLC = 17825792, O_PH = 17838080, O_PPOOL = 17842176, O_PFFN = 17903616,
                 O_SLC = 18001920, O_SH = 18198528, O_SPOOL = 18264064, O_SFFN = 19247104;

constexpr size_t MiB = 1u << 20;
constexpr size_t WS_WI = 1 * MiB, WS_WO = 4 * MiB, WS_WU = 6 * MiB, WS_WD = 18 * MiB;
constexpr size_t WS_WA = 24 * MiB, WS_WX = WS_WA + 65536, WS_PW = WS_WX + 65536;
constexpr size_t WS_RS1 = 25 * MiB, WS_RSS2 = WS_RS1 + 131072;
constexpr size_t WS_EDGE = 27 * MiB;
constexpr size_t WS_XB = 34 * MiB;
constexpr size_t WS_MIX = 68 * MiB;
constexpr size_t WS_Z = 102 * MiB;
constexpr size_t WS_HL = 162 * MiB, WS_PP = 202 * MiB;
constexpr size_t WS_ACT = 102 * MiB;
constexpr size_t WS_PART = 68 * MiB;
constexpr size_t WS_PART2 = 204 * MiB;
constexpr size_t WS_SUMP = 242 * MiB, WS_SUMH = 245 * MiB;
constexpr size_t WS_XS = 248 * MiB;
constexpr size_t WS_END = 249 * MiB;
constexpr int CW_RED = 8192, CW_G3S = 8256, CW_PAN = 8320;

constexpr int LDS_BYTES = 147456 + 256;
constexpr int LDS_MISC = 147456;
constexpr int LDS_X = 131072;

__device__ __forceinline__ unsigned cvt_pk_bf16(float lo, float hi) { unsigned r; asm volatile("v_cvt_pk_bf16_f32 %0, %1, %2" : "=v"(r) : "v"(lo), "v"(hi)); return r; }
__device__ __forceinline__ float bf_lo(unsigned u) { return __builtin_bit_cast(float, u << 16); }
__device__ __forceinline__ float bf_hi(unsigned u) { return __builtin_bit_cast(float, u & 0xffff0000u); }
__device__ __forceinline__ float bf_one(bf16_t u) { return __builtin_bit_cast(float, (unsigned)u << 16); }
__device__ __forceinline__ float wave_sum(float v) {
#pragma unroll
    for (int o = 1; o < 64; o <<= 1) v += __shfl_xor(v, o);
    return v;
}
#define DPP_SHR(n) (0x110 + (n))
#define DPP_ROR(n) (0x120 + (n))
template <int CTRL> __device__ __forceinline__ unsigned dppu(unsigned old, unsigned src) { return (unsigned)__builtin_amdgcn_update_dpp((int)old, (int)src, CTRL, 0xf, 0xf, false); }
template <int CTRL> __device__ __forceinline__ float dppf(float old, float src) {
    return __builtin_bit_cast(float, __builtin_amdgcn_update_dpp(__builtin_bit_cast(int, old), __builtin_bit_cast(int, src), CTRL, 0xf, 0xf, false));
}
template <int CTRL> __device__ __forceinline__ float dppf_all(float src) {
    return __builtin_bit_cast(float, __builtin_amdgcn_mov_dpp(__builtin_bit_cast(int, src), CTRL, 0xf, 0xf, false));
}
template <int CTRL> __device__ __forceinline__ unsigned dppu_all(unsigned src) { return (unsigned)__builtin_amdgcn_mov_dpp((int)src, CTRL, 0xf, 0xf, false); }
template <int Dd> __device__ __forceinline__ unsigned shiftu(unsigned prev, unsigned cur) { return dppu<DPP_SHR(Dd)>(dppu_all<DPP_ROR(Dd)>(prev), cur); }
template <int Dd> __device__ __forceinline__ float shiftf(float prev, float cur) { return dppf<DPP_SHR(Dd)>(dppf_all<DPP_ROR(Dd)>(prev), cur); }

__device__ __forceinline__ float sigmoidf_(float x) { return __builtin_amdgcn_rcpf(1.0f + __builtin_amdgcn_exp2f(-1.4426950409f * x)); }
__device__ __forceinline__ float gelu_tanh(float x) {
    const float k = -2.302208198f;
    const float p = x * (k + (k * 0.044715f) * (x * x));
    return x * __builtin_amdgcn_rcpf(1.0f + __builtin_amdgcn_exp2f(p));
}

namespace pg8 {
constexpr int BM = 256, BK = 64, HALF = 128, HTB = HALF * BK * 2, STAGE_BYTES = 8 * HTB, NXCD = 8, WGM = 8;
__host__ __device__ __forceinline__ int lds_byte(int r, int c) { const int st = (r >> 4) * 2 + (c >> 5), rr = r & 15, cc = c & 31, ob = rr * 64 + cc * 2; return st * 1024 + (ob ^ (((ob >> 9) & 1) << 5)); }
__host__ __device__ __forceinline__ void stage_rc(int b, int& R, int& C) { const int st = b / 1024, sb = b % 1024, swz = sb ^ (((sb >> 9) & 1) << 5); R = (st >> 1) * 16 + swz / 64; C = (st & 1) * 32 + (swz % 64) / 2; }
__host__ __device__ __forceinline__ int perm32(int rho) { const int n = rho >> 4, i = rho & 15; return 8 * (i >> 2) + 4 * n + (i & 3); }

struct Unit { int pm, pn, k0; };
struct Gemm { const bf16_t* A; const bf16_t* Bt; int M, N, K, ld; };

struct StaticOrder {
    int nM, nN, nwg, G, c;
    __host__ __device__ void init(int M_, int N_, int G_, int c_) { nM = M_ / BM; nN = N_ / BM; nwg = nM * nN; G = G_; c = c_; }
    __host__ __device__ bool next(int i, Unit& u) const {
        const long L = (long)i * G + c; if (L >= nwg) return false;
        int wgid = (int)L; { const int q = nwg / NXCD, r = nwg % NXCD, xcd = wgid % NXCD, off = wgid / NXCD; wgid = (xcd < r ? xcd * (q + 1) : r * (q + 1) + (xcd - r) * q) + off; }
        const int nig = WGM * nN, gid = wgid / nig, fm = gid * WGM, gsz = (nM - fm) < WGM ? (nM - fm) : WGM;
        u.pm = fm + ((wgid % nig) % gsz); u.pn = (wgid % nig) / gsz; u.k0 = 0; return true;
    }
    __device__ __forceinline__ void a_ready(const Unit&) const {}
    __device__ __forceinline__ void done(const Unit&) const {}
};

struct SplitOrder {
    int G, c, nsplit, klen;
    __host__ __device__ bool next(int i, Unit& u) const {
        const int L = i * G + c; if (L >= 16 * nsplit) return false;
        const int tile = L / nsplit, ks = L % nsplit; u.pm = 64 + (tile >> 2); u.pn = tile & 3; u.k0 = ks * klen; return true;
    }
    __device__ __forceinline__ void a_ready(const Unit&) const {}
    __device__ __forceinline__ void done(const Unit&) const {}
};

struct FfnOrder {
    StaticOrder P; int G, c; unsigned* cnt;
    __device__ bool next(int i, Unit& u) const {
        const int L = i * G + c; if (L < P.nwg) return P.next(i, u);
        const int s = L - P.nwg; if (s >= 96) return false;
        u.pm = 64 + s / 24; u.pn = s % 24; u.k0 = 0; return true;
    }
    __device__ __forceinline__ void a_ready(const Unit& u) const {
        if (u.pm >= 64) { unsigned sp = 0; while (__hip_atomic_load(cnt, __ATOMIC_RELAXED, __HIP_MEMORY_SCOPE_AGENT) < (unsigned)G && ++sp < (1u << 22)) __builtin_amdgcn_s_sleep(2);
            __builtin_amdgcn_fence(__ATOMIC_ACQUIRE, "agent"); asm volatile("s_waitcnt vmcnt(0)" ::: "memory"); }
    }
    __device__ __forceinline__ void done(const Unit&) const {}
};

struct SampleFfnOrder {
    int idx, G;
    __device__ bool next(int i, Unit& u) const { if (idx < 0) return false; const int L = idx + i * G; if (L >= 96) return false; u.pm = 64 + L / 24; u.pn = L % 24; u.k0 = 0; return true; }
    __device__ __forceinline__ void a_ready(const Unit&) const {}
    __device__ __forceinline__ void done(const Unit&) const {}
};
struct GatedSplitOrder {
    int idx, G, nsplit, klen; unsigned* cnt; unsigned want;
    __device__ bool next(int i, Unit& u) const {
        if (idx < 0) return false; const int L = idx + i * G; if (L >= 16 * nsplit) return false;
        const int tile = L / nsplit, ks = L % nsplit; u.pm = 64 + (tile >> 2); u.pn = tile & 3; u.k0 = ks * klen; return true;
    }
    __device__ __forceinline__ void a_ready(const Unit&) const {
        unsigned sp = 0; while (__hip_atomic_load(cnt, __ATOMIC_RELAXED, __HIP_MEMORY_SCOPE_AGENT) < want && ++sp < (1u << 22)) __builtin_amdgcn_s_sleep(2);
        __builtin_amdgcn_fence(__ATOMIC_ACQUIRE, "agent"); asm volatile("s_waitcnt vmcnt(0)" ::: "memory");
    }
    __device__ __forceinline__ void done(const Unit&) const {}
};

template <class Epi, class Sched, bool ALIGN_EPI = false, bool SP2 = false>
__device__ __forceinline__ void gemm_phase(LAS unsigned char* lds, const Gemm g, const Sched& S, const Epi& E) {
    int tid = threadIdx.x; asm volatile("" : "+v"(tid));
    const int wid = __builtin_amdgcn_readfirstlane(tid >> 6), lane = tid & 63, wr = wid >> 2, wc = wid & 3, fr = lane & 15, fq = lane >> 4;
    const int K = g.ld, nt = g.K / BK;
    unsigned voffA[2], voffB[2];
#pragma unroll
    for (int i = 0; i < 2; ++i) { int R, C; stage_rc(tid * 16 + i * 8192, R, C); const int Rb = Epi::PERM ? ((R & ~31) + perm32(R & 31)) : R;
        voffA[i] = (unsigned)(R * K + C) * 2u; voffB[i] = (unsigned)(Rb * K + C) * 2u; }
    const size_t kstep = (size_t)(BK * 2);
    const size_t hstep = (size_t)HALF * K * 2;
    const size_t tstep = 2 * hstep;
    const unsigned ldsw = (unsigned)wid * 1024u;
    const int aoff = lds_byte(wr * 64 + fr, fq * 8), boff = lds_byte(wc * 32 + fr, fq * 8);
#define PG8_SA(b, h) (((b) * 2 + (h)) * HTB)
#define PG8_SB(b, h) ((4 + (b) * 2 + (h)) * HTB)
#define PG8_STAGE(bufoff, gbase, voff) do { _Pragma("unroll") for (int _i = 0; _i < 2; ++_i) \
        __builtin_amdgcn_global_load_lds((const unsigned*)((const char*)(gbase) + (voff)[_i]), (LAS unsigned*)(lds + (bufoff) + ldsw + _i * 8192), 16, 0, 0); } while (0)
#define PG8_LDA(dst, b, h) do { _Pragma("unroll") for (int m = 0; m < 4; ++m) _Pragma("unroll") for (int k = 0; k < 2; ++k) dst[m][k] = *(const LAS bf16x8*)(lds + PG8_SA(b, h) + aoff + m * 2048 + k * 1024); } while (0)
#define PG8_LDB(dst, b, h) do { _Pragma("unroll") for (int n = 0; n < 2; ++n) _Pragma("unroll") for (int k = 0; k < 2; ++k) dst[n][k] = *(const LAS bf16x8*)(lds + PG8_SB(b, h) + boff + n * 2048 + k * 1024); } while (0)
#define PG8_MMA(ai, bj, At, Bt) do { __builtin_amdgcn_s_setprio(1); _Pragma("unroll") for (int m = 0; m < 4; ++m) _Pragma("unroll") for (int n = 0; n < 2; ++n) _Pragma("unroll") for (int k = 0; k < 2; ++k) \
        acc[ai][bj][m][n] = __builtin_amdgcn_mfma_f32_16x16x32_bf16(Bt[n][k], At[m][k], acc[ai][bj][m][n], 0, 0, 0); __builtin_amdgcn_s_setprio(0); } while (0)
#define PG8_WAIT_V(n) asm volatile("s_waitcnt vmcnt(" #n ")" ::: "memory")
#define PG8_WAIT_L(n) asm volatile("s_waitcnt lgkmcnt(" #n ")" ::: "memory")
#define PG8_BAR __builtin_amdgcn_s_barrier()
#define PG8_SCHED __builtin_amdgcn_sched_barrier(0)
    Unit cur, nxt; int ui = 0;
    if (!S.next(0, cur)) return;
    f32x4 acc[2][2][4][2];
#pragma unroll
    for (int a = 0; a < 2; ++a)
#pragma unroll
        for (int b = 0; b < 2; ++b)
#pragma unroll
            for (int m = 0; m < 4; ++m)
#pragma unroll
                for (int n = 0; n < 2; ++n) acc[a][b][m][n] = (f32x4){0.f, 0.f, 0.f, 0.f};
    bf16x8 At[4][2], B0[2][2], B1[2][2];
    const char* cA = (const char*)g.A + (size_t)cur.pm * tstep + (size_t)cur.k0 * 2; const char* cB = (const char*)g.Bt + (size_t)cur.pn * tstep + (size_t)cur.k0 * 2;
    S.a_ready(cur);
    if constexpr (SP2) {
        PG8_STAGE(PG8_SB(0, 0), cB, voffB); PG8_STAGE(PG8_SB(0, 1), cB + hstep, voffB); PG8_STAGE(PG8_SA(0, 0), cA, voffA); PG8_STAGE(PG8_SA(0, 1), cA + hstep, voffA);
        if (wr == 1) PG8_BAR;
        PG8_WAIT_V(2); PG8_BAR;
        PG8_STAGE(PG8_SB(1, 0), cB + kstep, voffB); PG8_STAGE(PG8_SA(1, 0), cA + kstep, voffA); PG8_STAGE(PG8_SB(1, 1), cB + hstep + kstep, voffB);
        PG8_WAIT_V(6); PG8_BAR;
    } else {
        PG8_STAGE(PG8_SB(0, 0), cB, voffB); PG8_STAGE(PG8_SA(0, 0), cA, voffA); PG8_STAGE(PG8_SB(0, 1), cB + hstep, voffB); PG8_STAGE(PG8_SA(0, 1), cA + hstep, voffA);
        if (wr == 1) PG8_BAR;
        PG8_WAIT_V(4); PG8_BAR;
        PG8_STAGE(PG8_SB(1, 0), cB + kstep, voffB); PG8_STAGE(PG8_SA(1, 0), cA + kstep, voffA); PG8_STAGE(PG8_SB(1, 1), cB + hstep + kstep, voffB);
        PG8_WAIT_V(6); PG8_BAR;
    }
    for (;;) {
        const bool has_next = S.next(ui + 1, nxt);
        const char* nA = has_next ? (const char*)g.A + (size_t)nxt.pm * tstep + (size_t)nxt.k0 * 2 : cA; const char* nB = has_next ? (const char*)g.Bt + (size_t)nxt.pn * tstep + (size_t)nxt.k0 * 2 : cB;
        for (int t = 0; t < nt; t += 2) {
            const bool last = (t == nt - 2);
            const char* a1 = cA + (size_t)(t + 1) * kstep;
            const char* a2 = last ? nA : cA + (size_t)(t + 2) * kstep; const char* b2 = last ? nB : cB + (size_t)(t + 2) * kstep;
            const char* a3 = a2 + kstep; const char* b3 = b2 + kstep;
            if (last && has_next) S.a_ready(nxt);
            if constexpr (SP2) {
            PG8_LDB(B0, 0, 0); PG8_LDB(B1, 0, 1); PG8_SCHED; PG8_LDA(At, 0, 0); PG8_STAGE(PG8_SA(1, 1), a1 + hstep, voffA);
            PG8_WAIT_V(8); PG8_WAIT_L(0); PG8_BAR; PG8_MMA(0, 0, At, B0); PG8_MMA(0, 1, At, B1); PG8_BAR; PG8_SCHED;
            PG8_LDA(At, 0, 1); PG8_STAGE(PG8_SB(0, 0), b2, voffB); PG8_STAGE(PG8_SB(0, 1), b2 + hstep, voffB); PG8_STAGE(PG8_SA(0, 0), a2, voffA);
            PG8_WAIT_V(8); PG8_WAIT_L(0); PG8_BAR; PG8_MMA(1, 0, At, B0); PG8_MMA(1, 1, At, B1); PG8_BAR; PG8_SCHED;
            PG8_LDB(B0, 1, 0); PG8_LDB(B1, 1, 1); PG8_SCHED; PG8_LDA(At, 1, 0); PG8_STAGE(PG8_SA(0, 1), a2 + hstep, voffA);
            PG8_WAIT_V(8); PG8_WAIT_L(0); PG8_BAR; PG8_MMA(0, 0, At, B0); PG8_MMA(0, 1, At, B1); PG8_BAR; PG8_SCHED;
            PG8_LDA(At, 1, 1); PG8_STAGE(PG8_SB(1, 0), b3, voffB); PG8_STAGE(PG8_SB(1, 1), b3 + hstep, voffB); PG8_STAGE(PG8_SA(1, 0), a3, voffA);
            PG8_WAIT_V(8); PG8_WAIT_L(0); PG8_BAR; PG8_MMA(1, 0, At, B0); PG8_MMA(1, 1, At, B1); PG8_BAR; PG8_SCHED;
            } else {
            PG8_LDB(B0, 0, 0); PG8_SCHED; PG8_LDA(At, 0, 0); PG8_STAGE(PG8_SA(1, 1), a1 + hstep, voffA);
            PG8_WAIT_L(8); PG8_BAR; PG8_WAIT_L(0); PG8_MMA(0, 0, At, B0); PG8_BAR; PG8_SCHED;
            PG8_LDB(B1, 0, 1); PG8_STAGE(PG8_SB(0, 0), b2, voffB);
            PG8_BAR; PG8_WAIT_L(0); PG8_MMA(0, 1, At, B1); PG8_BAR;
            PG8_LDA(At, 0, 1); PG8_STAGE(PG8_SA(0, 0), a2, voffA);
            PG8_BAR; PG8_WAIT_L(0); PG8_MMA(1, 0, At, B0); PG8_BAR; PG8_SCHED;
            PG8_STAGE(PG8_SB(0, 1), b2 + hstep, voffB);
            PG8_WAIT_V(6); PG8_BAR; PG8_MMA(1, 1, At, B1); PG8_BAR;
            PG8_LDB(B0, 1, 0); PG8_SCHED; PG8_LDA(At, 1, 0); PG8_STAGE(PG8_SA(0, 1), a2 + hstep, voffA);
            PG8_WAIT_L(8); PG8_BAR; PG8_WAIT_L(0); PG8_MMA(0, 0, At, B0); PG8_BAR; PG8_SCHED;
            PG8_LDB(B1, 1, 1); PG8_STAGE(PG8_SB(1, 0), b3, voffB);
            PG8_BAR; PG8_WAIT_L(0); PG8_MMA(0, 1, At, B1); PG8_BAR;
            PG8_LDA(At, 1, 1); PG8_STAGE(PG8_SA(1, 0), a3, voffA);
            PG8_BAR; PG8_WAIT_L(0); PG8_MMA(1, 0, At, B0); PG8_BAR; PG8_SCHED;
            PG8_STAGE(PG8_SB(1, 1), b3 + hstep, voffB);
            PG8_WAIT_V(6); PG8_BAR; PG8_MMA(1, 1, At, B1); PG8_BAR;
            }
        }
        if constexpr (ALIGN_EPI) { if (wr == 0) PG8_BAR; }
        E(acc, cur, wr, wc, fr, fq); S.done(cur);
        if (!has_next) break;
#pragma unroll
        for (int a = 0; a < 2; ++a)
#pragma unroll
            for (int b = 0; b < 2; ++b)
#pragma unroll
                for (int m = 0; m < 4; ++m)
#pragma unroll
                    for (int n = 0; n < 2; ++n) acc[a][b][m][n] = (f32x4){0.f, 0.f, 0.f, 0.f};
        cur = nxt; cA = nA; cB = nB; ++ui;
        if constexpr (ALIGN_EPI) { if (wr == 1) PG8_BAR; }
    }
    PG8_WAIT_V(0);
    if constexpr (!ALIGN_EPI) { if (wr == 0) PG8_BAR; }
    PG8_BAR;
#undef PG8_SA
#undef PG8_SB
#undef PG8_STAGE
#undef PG8_LDA
#undef PG8_LDB
#undef PG8_MMA
#undef PG8_WAIT_V
#undef PG8_WAIT_L
#undef PG8_BAR
#undef PG8_SCHED
}
}
using pg8::Unit;

#define EPI_IDS int tid_ = threadIdx.x; asm volatile("" : "+v"(tid_)); const int wid_ = __builtin_amdgcn_readfirstlane(tid_ >> 6), wr = wid_ >> 2, wc = wid_ & 3, fr = tid_ & 15, fq = (tid_ >> 4) & 3;
struct EpiZ {
    static constexpr bool PERM = true;
    bf16_t* Z; const float* rs1;
    __device__ __forceinline__ void operator()(const f32x4 (&acc)[2][2][4][2], const Unit& u, int, int, int, int) const {
        EPI_IDS
        const int row0 = u.pm * 256 + wr * 64 + fr, col0 = u.pn * 256 + wc * 32 + 8 * fq;
#pragma unroll
        for (int ai = 0; ai < 2; ++ai)
#pragma unroll
            for (int m = 0; m < 4; ++m) {
                const int row = row0 + ai * 128 + m * 16; const float s = rs1[row];
                const int orow = row < MP ? row : MP + ((row - MP) >> 3) * 32 + 24 + (row & 7);
                bf16_t* rowp = Z + (size_t)orow * DIN + col0;
#pragma unroll
                for (int bj = 0; bj < 2; ++bj) { const f32x4 v0 = acc[ai][bj][m][0] * s, v1 = acc[ai][bj][m][1] * s;
                    u32x4 w; w.x = cvt_pk_bf16(v0[0], v0[1]); w.y = cvt_pk_bf16(v0[2], v0[3]); w.z = cvt_pk_bf16(v1[0], v1[1]); w.w = cvt_pk_bf16(v1[2], v1[3]);
                    *(u32x4*)(rowp + bj * 128) = w; }
            }
    }
};
struct EpiX1 {
    static constexpr bool PERM = true;
    const float* xp; const float* xs; float* y; bf16_t* X1B; float* rss2;
    __device__ __forceinline__ void operator()(const f32x4 (&acc)[2][2][4][2], const Unit& u, int, int, int, int) const {
        EPI_IDS
        const int row0 = u.pm * 256 + wr * 64 + fr, col0 = u.pn * 256 + wc * 32 + 8 * fq;
#pragma unroll
        for (int ai = 0; ai < 2; ++ai)
#pragma unroll
            for (int m = 0; m < 4; ++m) {
                const int row = row0 + ai * 128 + m * 16;
                bf16_t* br = X1B + (size_t)row * D + col0; float ss = 0.f;
#pragma unroll
                for (int bj = 0; bj < 2; ++bj) { const u32x4 xb = __builtin_nontemporal_load((const u32x4*)(br + bj * 128));
                    const f32x4 v0 = acc[ai][bj][m][0] + (f32x4){bf_lo(xb.x), bf_hi(xb.x), bf_lo(xb.y), bf_hi(xb.y)}, v1 = acc[ai][bj][m][1] + (f32x4){bf_lo(xb.z), bf_hi(xb.z), bf_lo(xb.w), bf_hi(xb.w)};
                    u32x4 w; w.x = cvt_pk_bf16(v0[0], v0[1]); w.y = cvt_pk_bf16(v0[2], v0[3]); w.z = cvt_pk_bf16(v1[0], v1[1]); w.w = cvt_pk_bf16(v1[2], v1[3]);
                    *(u32x4*)(br + bj * 128) = w;
                    ss += (v0[0] * v0[0] + v0[1] * v0[1]) + (v0[2] * v0[2] + v0[3] * v0[3]) + (v1[0] * v1[0] + v1[1] * v1[1]) + (v1[2] * v1[2] + v1[3] * v1[3]); }
                ss += __shfl_xor(ss, 16); ss += __shfl_xor(ss, 32);
                if (fq == 0) rss2[(size_t)row * 16 + u.pn * 4 + wc] = ss;
            }
    }
};
struct EpiX2 {
    static constexpr bool PERM = true;
    float* y; const bf16_t* X1B;
    __device__ __forceinline__ void operator()(const f32x4 (&acc)[2][2][4][2], const Unit& u, int, int, int, int) const {
        EPI_IDS
        const int row0 = u.pm * 256 + wr * 64 + fr, col0 = u.pn * 256 + wc * 32 + 8 * fq;
#pragma unroll
        for (int ai = 0; ai < 2; ++ai)
#pragma unroll
            for (int m = 0; m < 4; ++m) {
                const size_t o = (size_t)(row0 + ai * 128 + m * 16) * D + col0; float* yr = y + o;
#pragma unroll
                for (int bj = 0; bj < 2; ++bj) { const u32x4 xb = *(const u32x4*)(X1B + o + bj * 128);
                    const f32x4 v0 = acc[ai][bj][m][0] + (f32x4){bf_lo(xb.x), bf_hi(xb.x), bf_lo(xb.y), bf_hi(xb.y)}, v1 = acc[ai][bj][m][1] + (f32x4){bf_lo(xb.z), bf_hi(xb.z), bf_lo(xb.w), bf_hi(xb.w)};
                    *(f32x4*)(yr + bj * 128) = v0; *(f32x4*)(yr + bj * 128 + 4) = v1; }
            }
    }
};
struct EpiX2N {
    static constexpr bool PERM = true;
    float* y; const bf16_t* X1B; const float* gf; float* xs; unsigned* pan; LAS unsigned char* lx;
    __device__ __forceinline__ void operator()(f32x4 (&acc)[2][2][4][2], const Unit& u, int, int, int, int) const {
        EPI_IDS
        LAS float* PS = (LAS float*)lx;
        LAS float* RT = PS + 1024;
        const int row0 = u.pm * 256 + wr * 64 + fr, col0 = u.pn * 256 + wc * 32 + 8 * fq;
#pragma unroll
        for (int ai = 0; ai < 2; ++ai)
#pragma unroll
            for (int m = 0; m < 4; ++m) {
                const size_t o = (size_t)(row0 + ai * 128 + m * 16) * D + col0; float ss = 0.f;
#pragma unroll
                for (int bj = 0; bj < 2; ++bj) { const u32x4 xb = __builtin_nontemporal_load((const u32x4*)(X1B + o + bj * 128));
                    acc[ai][bj][m][0] += (f32x4){bf_lo(xb.x), bf_hi(xb.x), bf_lo(xb.y), bf_hi(xb.y)}; acc[ai][bj][m][1] += (f32x4){bf_lo(xb.z), bf_hi(xb.z), bf_lo(xb.w), bf_hi(xb.w)};
                    const f32x4 v0 = acc[ai][bj][m][0], v1 = acc[ai][bj][m][1];
                    ss += (v0[0] * v0[0] + v0[1] * v0[1]) + (v0[2] * v0[2] + v0[3] * v0[3]) + (v1[0] * v1[0] + v1[1] * v1[1]) + (v1[2] * v1[2] + v1[3] * v1[3]); }
                ss += __shfl_xor(ss, 16); ss += __shfl_xor(ss, 32);
                if (fq == 0) PS[(ai * 128 + wr * 64 + m * 16 + fr) * 4 + wc] = ss;
            }
        asm volatile("s_waitcnt lgkmcnt(0)" ::: "memory"); __builtin_amdgcn_s_barrier(); asm volatile("" ::: "memory");
        float* slot = xs + ((size_t)u.pm * 256 + (tid_ & 255)) * 4;
        if (tid_ < 256) { const f32x4 p = *(const LAS f32x4*)(PS + tid_ * 4); __hip_atomic_store(slot + u.pn, (p[0] + p[1]) + (p[2] + p[3]), __ATOMIC_RELAXED, __HIP_MEMORY_SCOPE_AGENT); }
        asm volatile("s_waitcnt vmcnt(0)" ::: "memory"); __builtin_amdgcn_s_barrier(); asm volatile("" ::: "memory");
        if (tid_ == 0) {
            unsigned* c = pan + 64 * u.pm;
            __hip_atomic_fetch_add(c, 1u, __ATOMIC_RELAXED, __HIP_MEMORY_SCOPE_AGENT);
            unsigned sp = 0; while (__hip_atomic_load(c, __ATOMIC_RELAXED, __HIP_MEMORY_SCOPE_AGENT) < 4u && ++sp < (1u << 22)) __builtin_amdgcn_s_sleep(2);
            __builtin_amdgcn_fence(__ATOMIC_ACQUIRE, "agent"); asm volatile("s_waitcnt vmcnt(0)" ::: "memory");
        }
        __builtin_amdgcn_s_barrier(); asm volatile("" ::: "memory");
        if (tid_ < 256) { float t = 0.f;
#pragma unroll
            for (int k = 0; k < 4; ++k) t += __hip_atomic_load(slot + k, __ATOMIC_RELAXED, __HIP_MEMORY_SCOPE_AGENT);
            RT[tid_] = rsqrtf(t * (1.0f / D) + EPS); }
        asm volatile("s_waitcnt vmcnt(0) lgkmcnt(0)" ::: "memory"); __builtin_amdgcn_s_barrier(); asm volatile("" ::: "memory");
        f32x4 gv[2][2];
#pragma unroll
        for (int bj = 0; bj < 2; ++bj) { gv[bj][0] = *(const f32x4*)(gf + col0 + bj * 128); gv[bj][1] = *(const f32x4*)(gf + col0 + bj * 128 + 4); }
#pragma unroll
        for (int ai = 0; ai < 2; ++ai)
#pragma unroll
            for (int m = 0; m < 4; ++m) {
                const float r = RT[ai * 128 + wr * 64 + m * 16 + fr]; float* yr = y + (size_t)(row0 + ai * 128 + m * 16) * D + col0;
#pragma unroll
                for (int bj = 0; bj < 2; ++bj) { __builtin_nontemporal_store(acc[ai][bj][m][0] * r * gv[bj][0], (f32x4*)(yr + bj * 128)); __builtin_nontemporal_store(acc[ai][bj][m][1] * r * gv[bj][1], (f32x4*)(yr + bj * 128 + 4)); }
            }
    }
};
constexpr int KSPLIT = 4;
struct EpiPart {
    static constexpr bool PERM = true;
    float* part; int klen;
    __device__ __forceinline__ void operator()(const f32x4 (&acc)[2][2][4][2], const Unit& u, int, int, int, int) const {
        EPI_IDS
        const int row0 = (u.pm - 64) * 256 + wr * 64 + fr, col0 = u.pn * 256 + wc * 32 + 8 * fq;
        float* pb = part + (size_t)(u.k0 / klen) * MS * D;
#pragma unroll
        for (int ai = 0; ai < 2; ++ai)
#pragma unroll
            for (int m = 0; m < 4; ++m) {
                float* yr = pb + (size_t)(row0 + ai * 128 + m * 16) * D + col0;
#pragma unroll
                for (int bj = 0; bj < 2; ++bj) { *(f32x4*)(yr + bj * 128) = acc[ai][bj][m][0]; *(f32x4*)(yr + bj * 128 + 4) = acc[ai][bj][m][1]; }
            }
    }
};
template <bool SAMPLE_TILES> struct EpiFfn {
    static constexpr bool PERM = true;
    bf16_t* ACT; const float* rss2; const float* cw; const float* cb; const float* stf; float* edge; float* outp; float* outs; LAS unsigned char* lx;
    template <bool SAMPLE>
    __device__ __forceinline__ void body(f32x4 (&acc)[2][2][4][2], const Unit& u, int, int, int, int) const {
        LAS float* RS = (LAS float*)lx; LAS float* XCH = RS + 256;
        int tid = threadIdx.x; asm volatile("" : "+v"(tid));
        const int wid = __builtin_amdgcn_readfirstlane(tid >> 6), wr = wid >> 2, wc = wid & 3, fr = tid & 15, fq = (tid >> 4) & 3;
        { const int row = tid >> 1, half = tid & 1; const f32x4* p = (const f32x4*)(rss2 + (size_t)(u.pm * 256 + row) * 16 + half * 8);
          const f32x4 a = p[0], b = p[1]; float s = ((a[0] + a[1]) + (a[2] + a[3])) + ((b[0] + b[1]) + (b[2] + b[3]));
          s += __shfl_xor(s, 1);
          if (!half) RS[row] = rsqrtf(s * (1.0f / D) + EPS); }
        asm volatile("s_waitcnt lgkmcnt(0)" ::: "memory"); __builtin_amdgcn_s_barrier(); asm volatile("" ::: "memory");
        const int cw0 = wc * 32 + 8 * fq;
        const LAS float* rsw = RS + wr * 64 + fr;
        if (!SAMPLE) {
            if (fr >= 14) {
#pragma unroll
                for (int ai = 0; ai < 2; ++ai) { const int seg = 2 * ai + wr; const float s = rsw[ai * 128 + 48];
                    if (seg < 3) {
#pragma unroll
                        for (int bj = 0; bj < 2; ++bj)
#pragma unroll
                            for (int n = 0; n < 2; ++n) *(LAS f32x4*)(XCH + (seg * 2 + (fr - 14)) * 256 + bj * 128 + cw0 + 4 * n) = acc[ai][bj][3][n] * s; } }
            }
            if (wr == 0 && fr < 2) { float* e = edge + ((size_t)u.pm * 4 + fr) * FF2 + u.pn * 128 + cw0; const float s = rsw[0];
#pragma unroll
                for (int bj = 0; bj < 2; ++bj)
#pragma unroll
                    for (int n = 0; n < 2; ++n) *(f32x4*)(e + bj * FF + 4 * n) = acc[0][bj][0][n] * s; }
            if (wr == 1 && fr >= 14) { float* e = edge + ((size_t)u.pm * 4 + 2 + (fr - 14)) * FF2 + u.pn * 128 + cw0; const float s = rsw[128 + 48];
#pragma unroll
                for (int bj = 0; bj < 2; ++bj)
#pragma unroll
                    for (int n = 0; n < 2; ++n) *(f32x4*)(e + bj * FF + 4 * n) = acc[1][bj][3][n] * s;
                if ((u.pm & 7) == 7) { float* o = outp + ((size_t)(u.pm >> 3) * 2 + (fr - 14)) * FF2 + u.pn * 128 + cw0;
#pragma unroll
                    for (int bj = 0; bj < 2; ++bj)
#pragma unroll
                        for (int n = 0; n < 2; ++n) *(f32x4*)(o + bj * FF + 4 * n) = acc[1][bj][3][n] * s; } }
        } else {
            if ((fr & 7) >= 6) {
#pragma unroll
                for (int ai = 0; ai < 2; ++ai)
#pragma unroll
                    for (int m = 0; m < 4; ++m) { const int b = ((u.pm - 64) * 256 + ai * 128 + wr * 64 + m * 16 + fr) >> 3; const float s = rsw[ai * 128 + m * 16];
                        float* o = outs + ((size_t)b * 2 + ((fr & 7) - 6)) * FF2 + u.pn * 128 + cw0;
#pragma unroll
                        for (int bj = 0; bj < 2; ++bj)
#pragma unroll
                            for (int n = 0; n < 2; ++n) *(f32x4*)(o + bj * FF + 4 * n) = acc[ai][bj][m][n] * s; }
            }
        }
        f32x2 wq[8];
        { const int g0 = u.pn * 128 + cw0, v0 = FF + g0;
          wq[0] = *(const f32x2*)(cw + g0); wq[1] = *(const f32x2*)(cw + FF2 + g0); wq[2] = *(const f32x2*)(cw + 2 * FF2 + g0); wq[3] = *(const f32x2*)(cb + g0);
          wq[4] = *(const f32x2*)(cw + v0); wq[5] = *(const f32x2*)(cw + FF2 + v0); wq[6] = *(const f32x2*)(cw + 2 * FF2 + v0); wq[7] = *(const f32x2*)(cb + v0); }
        asm volatile("s_waitcnt lgkmcnt(0)" ::: "memory"); __builtin_amdgcn_s_barrier(); asm volatile("" ::: "memory");
        unsigned keep[2][2][2][4];
#pragma unroll
        for (int n = 0; n < 2; ++n)
#pragma unroll
        for (int jp = 0; jp < 2; ++jp) {
            __builtin_amdgcn_sched_barrier(0);
            const int c0 = cw0 + 4 * n + 2 * jp, gcol = u.pn * 128 + c0, vcol = FF + gcol;
            const f32x2 wg0 = wq[0], wg1 = wq[1], wg2 = wq[2], bg = wq[3], wv0 = wq[4], wv1 = wq[5], wv2 = wq[6], bv = wq[7];
            if (2 * n + jp < 3) { const int gn = gcol + (jp == 0 ? 2 : 2), vn = FF + gn;
                wq[0] = *(const f32x2*)(cw + gn); wq[1] = *(const f32x2*)(cw + FF2 + gn); wq[2] = *(const f32x2*)(cw + 2 * FF2 + gn); wq[3] = *(const f32x2*)(cb + gn);
                wq[4] = *(const f32x2*)(cw + vn); wq[5] = *(const f32x2*)(cw + FF2 + vn); wq[6] = *(const f32x2*)(cw + 2 * FF2 + vn); wq[7] = *(const f32x2*)(cb + vn); }
            f32x2 p1g, p2g, p1v, p2v;
#pragma unroll
            for (int ai = 0; ai < 2; ++ai) {
                if (!SAMPLE) {
                    const int seg = 2 * ai + wr;
                    if (seg == 0) { p1g = p2g = p1v = p2v = (f32x2){0.f, 0.f}; }
                    else { const LAS float* xb = XCH + (seg - 1) * 512 + c0;
                        p1g = *(const LAS f32x2*)(xb + 256); p2g = *(const LAS f32x2*)(xb + (fr & 1) * 256);
                        p1v = *(const LAS f32x2*)(xb + 256 + 128); p2v = *(const LAS f32x2*)(xb + (fr & 1) * 256 + 128); }
                }
#pragma unroll
                for (int m = 0; m < 4; ++m) {
                    const float s = rsw[ai * 128 + m * 16];
                    const f32x2 g = (f32x2){acc[ai][0][m][n][2 * jp], acc[ai][0][m][n][2 * jp + 1]} * s, v = (f32x2){acc[ai][1][m][n][2 * jp], acc[ai][1][m][n][2 * jp + 1]} * s;
                    f32x2 g1, g2, v1, v2;
                    if (!SAMPLE) {
#pragma unroll
                        for (int j = 0; j < 2; ++j) { g1[j] = dppf<DPP_SHR(1)>(p1g[j], g[j]); g2[j] = dppf<DPP_SHR(2)>(p2g[j], g[j]);
                            v1[j] = dppf<DPP_SHR(1)>(p1v[j], v[j]); v2[j] = dppf<DPP_SHR(2)>(p2v[j], v[j]); }
#pragma unroll
                        for (int j = 0; j < 2; ++j) { p1g[j] = dppf_all<DPP_ROR(1)>(g[j]); p2g[j] = dppf_all<DPP_ROR(2)>(g[j]);
                            p1v[j] = dppf_all<DPP_ROR(1)>(v[j]); p2v[j] = dppf_all<DPP_ROR(2)>(v[j]); }
                    } else {
                        const int b = ((u.pm - 64) * 256 + ai * 128 + wr * 64 + m * 16 + fr) >> 3, sq = fr & 7;
#pragma unroll
                        for (int j = 0; j < 2; ++j) { g1[j] = dppf<DPP_SHR(1)>(0.f, g[j]); g2[j] = dppf<DPP_SHR(2)>(0.f, g[j]);
                            v1[j] = dppf<DPP_SHR(1)>(0.f, v[j]); v2[j] = dppf<DPP_SHR(2)>(0.f, v[j]); }
                        {
                            const float* sp = stf + (size_t)b * 2 * FF2; const int ra = sq < 1 ? 0 : FF2;
                            const f32x2 ag = *(const f32x2*)(sp + ra + gcol), av = *(const f32x2*)(sp + ra + vcol), bg1 = *(const f32x2*)(sp + FF2 + gcol), bv1 = *(const f32x2*)(sp + FF2 + vcol);
                            if (sq < 2) { g2 = ag; v2 = av; }
                            if (sq == 0) { g1 = bg1; v1 = bv1; } }
                    }
                    const f32x2 ug = bg + wg0 * g2 + wg1 * g1 + wg2 * g, uv = bv + wv0 * v2 + wv1 * v1 + wv2 * v;
                    keep[n][jp][ai][m] = cvt_pk_bf16(gelu_tanh(ug[0]) * uv[0], gelu_tanh(ug[1]) * uv[1]);
                }
            }
        }
        __builtin_amdgcn_sched_barrier(0);
#pragma unroll
        for (int ai = 0; ai < 2; ++ai)
#pragma unroll
            for (int m = 0; m < 4; ++m)
                *(u32x4*)(ACT + (size_t)(u.pm * 256 + ai * 128 + wr * 64 + m * 16 + fr) * FF + u.pn * 128 + cw0) = (u32x4){keep[0][0][ai][m], keep[0][1][ai][m], keep[1][0][ai][m], keep[1][1][ai][m]};
    }
    __device__ __forceinline__ void operator()(f32x4 (&acc)[2][2][4][2], const Unit& u, int wr, int wc, int fr, int fq) const { body<SAMPLE_TILES>(acc, u, wr, wc, fr, fq); }
};

struct Args { const float* in[24]; float* out; unsigned char* ws; int ph_lo, ph_hi; };
enum { I_XP = 0, I_XS, I_SLC, I_SH, I_SPOOL, I_SFFN, I_G1, I_WIN, I_LCW, I_LCB, I_WA, I_BA, I_WX, I_BX, I_LAM, I_PW, I_PSC, I_WOUT, I_G2, I_UP, I_FCW, I_FCB, I_DOWN, I_GF };

__device__ __forceinline__ void p0_transpose_item(const float* W, int K, int N, bf16_t* WT, const float* kscale, bool up_map, LAS float* scr, int item, int lane) {
    const int nblk = N / 32, kb = item / nblk, nb = item % nblk, k0 = 64 * kb, n0 = 32 * nb;
    int drow0 = n0;
    if (up_map) { const int bj = n0 / FF, f = n0 % FF; drow0 = 256 * (f >> 7) + 128 * bj + (f & 127); }
    float tv[32];
#pragma unroll
    for (int i = 0; i < 32; ++i) { const int kk = 2 * i + (lane >> 5); tv[i] = __builtin_nontemporal_load(W + (size_t)(k0 + kk) * N + n0 + (lane & 31)); }
    if (kscale) {
#pragma unroll
        for (int i = 0; i < 32; ++i) tv[i] *= kscale[k0 + 2 * i + (lane >> 5)];
    }
#pragma unroll
    for (int i = 0; i < 32; ++i) scr[(2 * i + (lane >> 5)) * 33 + (lane & 31)] = tv[i];
    asm volatile("s_waitcnt lgkmcnt(0)" ::: "memory");
    const int c = lane & 7;
#pragma unroll
    for (int j = 0; j < 4; ++j) { const int n = (lane >> 3) + 8 * j; const LAS float* s = scr + (8 * c) * 33 + n;
        u32x4 o; o.x = cvt_pk_bf16(s[0 * 33], s[1 * 33]); o.y = cvt_pk_bf16(s[2 * 33], s[3 * 33]); o.z = cvt_pk_bf16(s[4 * 33], s[5 * 33]); o.w = cvt_pk_bf16(s[6 * 33], s[7 * 33]);
        *(u32x4*)(WT + (size_t)(drow0 + n) * K + k0 + 8 * c) = o; }
    asm volatile("s_waitcnt lgkmcnt(0)" ::: "memory");
}

struct MixCtx { const bf16_t* Z; unsigned* HP; float* SUMP; float* SUMH; bf16_t* MIX; const float* pscale; };

__device__ __forceinline__ void blk_desc(int blk, int& zrow0, bool& hasprev, int& segmask) {
    if (blk < 1024) { zrow0 = blk * 16; hasprev = (blk & 127) != 0; segmask = 15; }
    else { zrow0 = MP + (blk - 1024) * 32 + 16; hasprev = true; segmask = 7; }
}

__device__ __forceinline__ void lru_load(const MixCtx& C, int h, int blk, int lane, u32x4 (&zc)[2], u32x4 (&zq)[2]) {
    const int r = lane & 15, q = lane >> 4;
    int zrow0, segmask; bool hasprev; blk_desc(blk, zrow0, hasprev, segmask);
    const bf16_t* zp = C.Z + (size_t)(zrow0 + r) * DIN + h * 64 + q * 8;
    zc[0] = __builtin_nontemporal_load((const u32x4*)zp); zc[1] = __builtin_nontemporal_load((const u32x4*)(zp + 32));
    zq[0] = zq[1] = (u32x4){0u, 0u, 0u, 0u};
    if (hasprev) { zq[0] = *(const u32x4*)(zp - 16 * DIN); zq[1] = *(const u32x4*)(zp - 16 * DIN + 32); }
}
__device__ __forceinline__ void lru_item(const MixCtx& C, int h, int blk, const bf16x8 (&WA)[4][2], const bf16x8 (&WX)[4][2], const LAS float* KC, int lane, const u32x4 (&zc)[2], const u32x4 (&zq)[2]) {
    const int r = lane & 15, q = lane >> 4;
    int zrow0, segmask; bool hasprev; blk_desc(blk, zrow0, hasprev, segmask);
    float xc[2][8]; bf16x8 Bf[2];
#pragma unroll
    for (int kb = 0; kb < 2; ++kb) {
        const LAS float* kc = KC + kb * 32 + q * 8;
        f32x4 w[4][2], bb[2];
#pragma unroll
        for (int t = 0; t < 4; ++t) { w[t][0] = *(const LAS f32x4*)(kc + t * 64); w[t][1] = *(const LAS f32x4*)(kc + t * 64 + 4); }
        bb[0] = *(const LAS f32x4*)(kc + 256); bb[1] = *(const LAS f32x4*)(kc + 260);
#pragma unroll
        for (int i2 = 0; i2 < 4; ++i2) {
            const unsigned c0 = zc[kb][i2], pv = zq[kb][i2];
            const unsigned s1 = shiftu<1>(pv, c0), s2 = shiftu<2>(pv, c0), s3 = shiftu<3>(pv, c0);
            const int e = 2 * i2, hh = e >> 2, ee = e & 3;
            xc[kb][e]     = bb[hh][ee]     + w[3][hh][ee]     * bf_lo(c0) + w[2][hh][ee]     * bf_lo(s1) + w[1][hh][ee]     * bf_lo(s2) + w[0][hh][ee]     * bf_lo(s3);
            xc[kb][e + 1] = bb[hh][ee + 1] + w[3][hh][ee + 1] * bf_hi(c0) + w[2][hh][ee + 1] * bf_hi(s1) + w[1][hh][ee + 1] * bf_hi(s2) + w[0][hh][ee + 1] * bf_hi(s3);
        }
        u32x4 pk; pk.x = cvt_pk_bf16(xc[kb][0], xc[kb][1]); pk.y = cvt_pk_bf16(xc[kb][2], xc[kb][3]); pk.z = cvt_pk_bf16(xc[kb][4], xc[kb][5]); pk.w = cvt_pk_bf16(xc[kb][6], xc[kb][7]);
        Bf[kb] = __builtin_bit_cast(bf16x8, pk);
    }
    const bool dead = (segmask == 7) && (r < 8);
    f32x4 R[4], I[4];
#pragma unroll
    for (int n = 0; n < 4; ++n) { R[n] = (f32x4){0.f, 0.f, 0.f, 0.f}; I[n] = R[n]; }
#pragma unroll
    for (int n = 0; n < 4; ++n) { R[n] = __builtin_amdgcn_mfma_f32_16x16x32_bf16(WA[n][0], Bf[0], R[n], 0, 0, 0); I[n] = __builtin_amdgcn_mfma_f32_16x16x32_bf16(WX[n][0], Bf[0], I[n], 0, 0, 0); }
#pragma unroll
    for (int n = 0; n < 4; ++n) { R[n] = __builtin_amdgcn_mfma_f32_16x16x32_bf16(WA[n][1], Bf[1], R[n], 0, 0, 0); I[n] = __builtin_amdgcn_mfma_f32_16x16x32_bf16(WX[n][1], Bf[1], I[n], 0, 0, 0); }
    float av[16], bv[16];
#pragma unroll
    for (int n = 0; n < 4; ++n) {
        const int kb = n >> 1, half = n & 1;
        const LAS float* kc = KC + kb * 32 + q * 8 + half * 4;
        const f32x4 ba = *(const LAS f32x4*)(kc + 320), bx = *(const LAS f32x4*)(kc + 384), sp = *(const LAS f32x4*)(kc + 448);
#pragma unroll
        for (int j = 0; j < 4; ++j) {
            const float rg = sigmoidf_(R[n][j] + ba[j]), ig = sigmoidf_(I[n][j] + bx[j]);
            const float la = (-8.0f * 1.4426950409f) * rg * sp[j];
            const float a = __builtin_amdgcn_exp2f(la);
            const float mm = 1.0f - a * a;
            av[n * 4 + j] = dead ? 1.0f : a;
            bv[n * 4 + j] = dead ? 0.0f : __builtin_amdgcn_sqrtf(mm) * ig * xc[kb][half * 4 + j];
        }
    }
#define SC8_STEP(d) \
        "v_fmac_f32_dpp %8, %8, %0 row_shr:" #d " row_mask:0xf bank_mask:0xf\n"   "v_fmac_f32_dpp %9, %9, %1 row_shr:" #d " row_mask:0xf bank_mask:0xf\n" \
        "v_fmac_f32_dpp %10, %10, %2 row_shr:" #d " row_mask:0xf bank_mask:0xf\n" "v_fmac_f32_dpp %11, %11, %3 row_shr:" #d " row_mask:0xf bank_mask:0xf\n" \
        "v_fmac_f32_dpp %12, %12, %4 row_shr:" #d " row_mask:0xf bank_mask:0xf\n" "v_fmac_f32_dpp %13, %13, %5 row_shr:" #d " row_mask:0xf bank_mask:0xf\n" \
        "v_fmac_f32_dpp %14, %14, %6 row_shr:" #d " row_mask:0xf bank_mask:0xf\n" "v_fmac_f32_dpp %15, %15, %7 row_shr:" #d " row_mask:0xf bank_mask:0xf\n" \
        "v_mul_f32_dpp %0, %0, %0 row_shr:" #d " row_mask:0xf bank_mask:0xf\n" "v_mul_f32_dpp %1, %1, %1 row_shr:" #d " row_mask:0xf bank_mask:0xf\n" \
        "v_mul_f32_dpp %2, %2, %2 row_shr:" #d " row_mask:0xf bank_mask:0xf\n" "v_mul_f32_dpp %3, %3, %3 row_shr:" #d " row_mask:0xf bank_mask:0xf\n" \
        "v_mul_f32_dpp %4, %4, %4 row_shr:" #d " row_mask:0xf bank_mask:0xf\n" "v_mul_f32_dpp %5, %5, %5 row_shr:" #d " row_mask:0xf bank_mask:0xf\n" \
        "v_mul_f32_dpp %6, %6, %6 row_shr:" #d " row_mask:0xf bank_mask:0xf\n" "v_mul_f32_dpp %7, %7, %7 row_shr:" #d " row_mask:0xf bank_mask:0xf\n"
#pragma unroll
    for (int hb = 0; hb < 2; ++hb) {
        asm volatile("s_nop 1\n" SC8_STEP(1) SC8_STEP(2) SC8_STEP(4) SC8_STEP(8)
                     : "+v"(av[hb * 8 + 0]), "+v"(av[hb * 8 + 1]), "+v"(av[hb * 8 + 2]), "+v"(av[hb * 8 + 3]), "+v"(av[hb * 8 + 4]), "+v"(av[hb * 8 + 5]), "+v"(av[hb * 8 + 6]), "+v"(av[hb * 8 + 7]),
                       "+v"(bv[hb * 8 + 0]), "+v"(bv[hb * 8 + 1]), "+v"(bv[hb * 8 + 2]), "+v"(bv[hb * 8 + 3]), "+v"(bv[hb * 8 + 4]), "+v"(bv[hb * 8 + 5]), "+v"(bv[hb * 8 + 6]), "+v"(bv[hb * 8 + 7]));
    }
#undef SC8_STEP
#pragma unroll
    for (int n = 0; n < 4; ++n) {
        const int kb = n >> 1, half = n & 1;
        const f32x4 a = {av[n * 4], av[n * 4 + 1], av[n * 4 + 2], av[n * 4 + 3]}, b = {bv[n * 4], bv[n * 4 + 1], bv[n * 4 + 2], bv[n * 4 + 3]};
        const int ch = h * 64 + kb * 32 + q * 8 + half * 4;
        u32x4 hp; hp.x = cvt_pk_bf16(b[0], a[0]); hp.y = cvt_pk_bf16(b[1], a[1]); hp.z = cvt_pk_bf16(b[2], a[2]); hp.w = cvt_pk_bf16(b[3], a[3]);
        *(u32x4*)(C.HP + (size_t)(zrow0 + r) * DL + ch) = hp;
        if (r == 15) { const size_t so = (size_t)(zrow0 >> 4) * DL + ch; *(f32x4*)(C.SUMP + so) = a; *(f32x4*)(C.SUMH + so) = b; }
    }
}

__device__ __forceinline__ void pool_load(const MixCtx& C, int g, int blk, int lane, u32x4 (&pc)[4], u32x4 (&pq)[4]) {
    const int r = lane & 15, q = lane >> 4;
    int zrow0, segmask; bool hasprev; blk_desc(blk, zrow0, hasprev, segmask);
    const bf16_t* zp = C.Z + (size_t)(zrow0 + r) * DIN + 1024 + g * 128 + q * 8;
#pragma unroll
    for (int ks = 0; ks < 4; ++ks) { pc[ks] = __builtin_nontemporal_load((const u32x4*)(zp + ks * 32)); pq[ks] = (u32x4){0u, 0u, 0u, 0u}; if (hasprev) pq[ks] = *(const u32x4*)(zp + ks * 32 - 16 * DIN); }
}
__device__ __forceinline__ void pool_item(const MixCtx& C, int g, int blk, const LAS unsigned char* PWL, int lane, const u32x4 (&pc)[4], const u32x4 (&pq)[4]) {
    const int r = lane & 15, q = lane >> 4;
    int zrow0, segmask; bool hasprev; blk_desc(blk, zrow0, hasprev, segmask);
    const bool prompt = blk < 1024;
    const int orow = prompt ? zrow0 + r : MP + (blk - 1024) * 8 + (r - 8);
    const bool valid = prompt || r >= 8;
    const int w = 2 << g;
    int cnt = w; if (prompt) { const int t1 = ((zrow0 + r) & 2047) + 1; cnt = t1 < w ? t1 : w; }
    const float inv = __builtin_amdgcn_rcpf((float)cnt);
    bf16x8 Bf[4];
#pragma unroll
    for (int ks = 0; ks < 4; ++ks) {
        const u32x4 c = pc[ks], p = pq[ks];
        float pl[8], xs[8], S[8], PS[8];
#pragma unroll
        for (int e = 0; e < 8; ++e) { xs[e] = (e & 1) ? bf_hi(c[e >> 1]) : bf_lo(c[e >> 1]); PS[e] = (e & 1) ? bf_hi(p[e >> 1]) : bf_lo(p[e >> 1]); S[e] = xs[e]; }
#pragma unroll
        for (int e = 0; e < 8; ++e) S[e] += shiftf<1>(PS[e], S[e]);
        if (g >= 1) {
#pragma unroll
            for (int e = 0; e < 8; ++e) PS[e] += dppf<DPP_SHR(1)>(0.f, PS[e]);
#pragma unroll
            for (int e = 0; e < 8; ++e) S[e] += shiftf<2>(PS[e], S[e]);
        }
        if (g >= 2) {
#pragma unroll
            for (int e = 0; e < 8; ++e) PS[e] += dppf<DPP_SHR(2)>(0.f, PS[e]);
#pragma unroll
            for (int e = 0; e < 8; ++e) S[e] += shiftf<4>(PS[e], S[e]);
        }
        if (g >= 3) {
#pragma unroll
            for (int e = 0; e < 8; ++e) PS[e] += dppf<DPP_SHR(4)>(0.f, PS[e]);
#pragma unroll
            for (int e = 0; e < 8; ++e) S[e] += shiftf<8>(PS[e], S[e]);
        }
#pragma unroll
        for (int e = 0; e < 8; ++e) pl[e] = S[e] * inv - xs[e];
        u32x4 pk; pk.x = cvt_pk_bf16(pl[0], pl[1]); pk.y = cvt_pk_bf16(pl[2], pl[3]); pk.z = cvt_pk_bf16(pl[4], pl[5]); pk.w = cvt_pk_bf16(pl[6], pl[7]);
        Bf[ks] = __builtin_bit_cast(bf16x8, pk);
    }
#pragma unroll
    for (int m2 = 0; m2 < 4; ++m2) {
        f32x4 y[2];
#pragma unroll
        for (int half = 0; half < 2; ++half) {
            const int out = m2 * 32 + (r >> 2) * 8 + half * 4 + (r & 3);
            const LAS unsigned char* wrow = PWL + (g * 128 + out) * 256;
            f32x4 Dv = {0.f, 0.f, 0.f, 0.f};
#pragma unroll
            for (int ks = 0; ks < 4; ++ks) { const bf16x8 A = *(const LAS bf16x8*)(wrow + (((ks * 4 + q) ^ r) << 4)); Dv = __builtin_amdgcn_mfma_f32_16x16x32_bf16(A, Bf[ks], Dv, 0, 0, 0); }
            const f32x4 sc = *(const f32x4*)(C.pscale + g * 128 + m2 * 32 + q * 8 + half * 4);
            y[half] = Dv * sc;
        }
        if (valid) { u32x4 pk; pk.x = cvt_pk_bf16(y[0][0], y[0][1]); pk.y = cvt_pk_bf16(y[0][2], y[0][3]); pk.z = cvt_pk_bf16(y[1][0], y[1][1]); pk.w = cvt_pk_bf16(y[1][2], y[1][3]);
            *(u32x4*)(C.MIX + (size_t)orow * D + 512 + g * 128 + m2 * 32 + q * 8) = pk; }
    }
}

#define XB_TMO      128
#define XB_XCNT(j)  (256  + 64 * (j))
#define XB_XSUB(j)  (1280 + 64 * (j))
#define XB_XGEN(j)  (2304 + 64 * (j))
#define XB_TOP      3328
#define XB_TOPGEN   3392
#define XCD_BAR_WORDS 3456
#define XB_SPIN_CAP (1u << 22)
__device__ __forceinline__ unsigned xb_ld(unsigned* p)              { return __hip_atomic_load(p, __ATOMIC_RELAXED, __HIP_MEMORY_SCOPE_AGENT); }
__device__ __forceinline__ unsigned xb_add(unsigned* p, unsigned v) { return __hip_atomic_fetch_add(p, v, __ATOMIC_RELAXED, __HIP_MEMORY_SCOPE_AGENT); }
__device__ __forceinline__ unsigned xb_xcc_id() { return (unsigned)__builtin_amdgcn_s_getreg((3 << 11) | 20) & 0xFu; }
#define XB_SPIN(cond, bar) do { unsigned _sp = 0; while (cond) { __builtin_amdgcn_s_sleep(1); \
    if ((++_sp & 255u) == 0u) { if (xb_ld(&(bar)[XB_TMO])) break; if (_sp > XB_SPIN_CAP) { atomicAdd(&(bar)[XB_TMO], 1u); break; } } } } while (0)
struct XcdBarrier { unsigned* bar; unsigned x; volatile LAS unsigned* st; };
__device__ __forceinline__ XcdBarrier xcd_barrier_post(unsigned* bar, volatile LAS unsigned* st) {
    XcdBarrier b; b.bar = bar; b.x = xb_xcc_id(); b.st = st;
    if (threadIdx.x == 0) (void)xb_add(&bar[XB_XCNT(b.x)], 1u);
    return b;
}
__device__ __forceinline__ void xcd_barrier_complete(unsigned* bar, unsigned x, unsigned& nloc, unsigned& nx) {
    const unsigned G = gridDim.x * gridDim.y * gridDim.z;
    unsigned sum, cnt, mine, sp = 0u;
    for (;;) {
        sum = 0u; cnt = 0u; mine = 0u;
#pragma unroll
        for (unsigned j = 0; j < 16; ++j) { const unsigned c = xb_ld(&bar[XB_XCNT(j)]); sum += c; cnt += (c > 0u) ? 1u : 0u; mine = (j == x) ? c : mine; }
        if (sum == G) break;
        __builtin_amdgcn_s_sleep(1);
        if ((++sp & 255u) == 0u) { if (xb_ld(&bar[XB_TMO])) break; if (sp > XB_SPIN_CAP) { atomicAdd(&bar[XB_TMO], 1u); break; } }
    }
    nloc = mine > 0u ? mine : 1u; nx = cnt > 0u ? cnt : 1u;
}
__device__ __forceinline__ void xcd_barrier(const XcdBarrier& b) {
    asm volatile("s_waitcnt vmcnt(0)" ::: "memory");
    __syncthreads();
    if (threadIdx.x == 0) {
        unsigned* bar = b.bar;
        __builtin_amdgcn_s_waitcnt(0);
        unsigned nloc = b.st[0], nx = b.st[1];
        if (nloc == 0u) { xcd_barrier_complete(bar, b.x, nloc, nx); b.st[0] = nloc; b.st[1] = nx; }
        const unsigned old = xb_add(&bar[XB_XSUB(b.x)], 1u);
        const unsigned gen = old / nloc;
        if (old + 1u == (gen + 1u) * nloc) {
            __builtin_amdgcn_fence(__ATOMIC_RELEASE, "agent");
            asm volatile("s_waitcnt vmcnt(0)" ::: "memory");
            const unsigned og = xb_add(&bar[XB_TOP], 1u);
            const unsigned tg = og / nx;
            if (og + 1u == (tg + 1u) * nx) xb_add(&bar[XB_TOPGEN], 1u);
            else XB_SPIN(xb_ld(&bar[XB_TOPGEN]) == tg, bar);
            __builtin_amdgcn_fence(__ATOMIC_ACQUIRE, "agent");
            xb_add(&bar[XB_XGEN(b.x)], 1u);
            asm volatile("s_waitcnt vmcnt(0)" ::: "memory");
        } else {
            XB_SPIN(xb_ld(&bar[XB_XGEN(b.x)]) == gen, bar);
            __builtin_amdgcn_fence(__ATOMIC_ACQUIRE, "agent");
            asm volatile("s_waitcnt vmcnt(0)" ::: "memory");
        }
    }
    __syncthreads();
}

__global__ void __launch_bounds__(512, 2) fwd_kernel(Args args) {
    extern __shared__ __attribute__((aligned(16))) unsigned char lds_raw[];
    LAS unsigned char* lds = (LAS unsigned char*)lds_raw;
    cg::grid_group grid = cg::this_grid();
    const int G = gridDim.x, NGW = G * 8, NGT = G * 512;
#define TID_SETUP int tid = threadIdx.x; asm volatile("" : "+v"(tid)); const int lane = tid & 63, wave = __builtin_amdgcn_readfirstlane(tid >> 6), gw = blockIdx.x * 8 + wave, gt = blockIdx.x * 512 + tid; (void)lane; (void)gw; (void)gt;
    unsigned char* ws = args.ws; float* out = args.out;
    bf16_t* Wi_t = (bf16_t*)(ws + WS_WI); bf16_t* Wo_t = (bf16_t*)(ws + WS_WO); bf16_t* Wu_t = (bf16_t*)(ws + WS_WU); bf16_t* Wd_t = (bf16_t*)(ws + WS_WD);
    bf16_t* WA_t = (bf16_t*)(ws + WS_WA); bf16_t* WX_t = (bf16_t*)(ws + WS_WX); bf16_t* PW_t = (bf16_t*)(ws + WS_PW);
    float* rs1 = (float*)(ws + WS_RS1); float* rss2 = (float*)(ws + WS_RSS2); float* edge = (float*)(ws + WS_EDGE);
    bf16_t* XB = (bf16_t*)(ws + WS_XB); bf16_t* MIX = (bf16_t*)(ws + WS_MIX); bf16_t* Z = (bf16_t*)(ws + WS_Z);
    unsigned* HP = (unsigned*)(ws + WS_HL); float* SUMP = (float*)(ws + WS_SUMP); float* SUMH = (float*)(ws + WS_SUMH); bf16_t* ACT = (bf16_t*)(ws + WS_ACT); float* part = (float*)(ws + WS_PART); float* part2 = (float*)(ws + WS_PART2);
    const int lo = args.ph_lo, hi = args.ph_hi;
#define IN(k) (lo <= (k) && (k) < hi)
#define REPS(k) ((((REP_MASK) >> (k)) & 1) + 1)
#define SEAM(k) do { if (IN(k) && IN((k) + 1)) xcd_barrier(bar); } while (0)
    for (int u_ = threadIdx.x; u_ < 64; u_ += 512) ((LAS unsigned*)(lds + LDS_MISC))[u_] = 0u;
    __syncthreads();
    XcdBarrier bar; bar.bar = (unsigned*)ws; bar.x = 0; bar.st = (volatile LAS unsigned*)(lds + LDS_MISC);
    if (hi - lo > 1) bar = xcd_barrier_post((unsigned*)ws, (volatile LAS unsigned*)(lds + LDS_MISC));
    unsigned long long ts0_ = 0, ts1_ = 0;
#define STAMP(k) do { if (TS_PHASE >= 0) { if ((k) == TS_PHASE - 1) ts0_ = __builtin_amdgcn_s_memrealtime(); if ((k) == TS_PHASE) ts1_ = __builtin_amdgcn_s_memrealtime(); } } while (0)
    STAMP(-1);
    if (hi > 1000) grid.sync();

    if (IN(0)) for (int rep_ = 0; rep_ < REPS(0); ++rep_) {
        if (rep_) xcd_barrier(bar);
        TID_SETUP
        LAS float* scr = (LAS float*)(lds + wave * 16384);
        constexpr int I_WI = 16 * 48, I_G = 8 * 2, I_P = 4 * 8;
        constexpr int NIT = I_WI + 2 * I_G + I_P;
        for (int it = gw; it < NIT; it += NGW) {
            int r = it;
            if (r < I_WI) { p0_transpose_item(args.in[I_WIN], D, DIN, Wi_t, args.in[I_G1], false, scr, r, lane); continue; } r -= I_WI;
            if (r < I_G) { p0_transpose_item(args.in[I_WA] + (r >> 1) * 4096, 64, 64, WA_t + (r >> 1) * 4096, nullptr, false, scr, r & 1, lane); continue; } r -= I_G;
            if (r < I_G) { p0_transpose_item(args.in[I_WX] + (r >> 1) * 4096, 64, 64, WX_t + (r >> 1) * 4096, nullptr, false, scr, r & 1, lane); continue; } r -= I_G;
            p0_transpose_item(args.in[I_PW] + (r >> 3) * 16384, 128, 128, PW_t + (r >> 3) * 16384, nullptr, false, scr, r & 7, lane);
        }
        for (int m0 = gw; m0 < M; m0 += 4 * NGW) {
            f32x4 v[4][4]; float s[4]; int mr[4]; bool ok[4];
#pragma unroll
            for (int r = 0; r < 4; ++r) { const int m = m0 + r * NGW; ok[r] = m < M; mr[r] = ok[r] ? m : m0;
                const float* xrow = mr[r] < MP ? args.in[I_XP] + (size_t)mr[r] * D : args.in[I_XS] + (size_t)(mr[r] - MP) * D; const f32x4* xr = (const f32x4*)xrow + lane;
#pragma unroll
                for (int j = 0; j < 4; ++j) v[r][j] = __builtin_nontemporal_load(xr + 64 * j); }
#pragma unroll
            for (int r = 0; r < 4; ++r) { s[r] = 0.f;
#pragma unroll
                for (int j = 0; j < 4; ++j) s[r] += (v[r][j][0] * v[r][j][0] + v[r][j][1] * v[r][j][1]) + (v[r][j][2] * v[r][j][2] + v[r][j][3] * v[r][j][3]); }
#pragma unroll
            for (int o = 1; o < 64; o <<= 1) {
#pragma unroll
                for (int r = 0; r < 4; ++r) s[r] += __shfl_xor(s[r], o); }
#pragma unroll
            for (int r = 0; r < 4; ++r) if (ok[r]) {
                if (lane == 0) rs1[mr[r]] = rsqrtf(s[r] * (1.0f / D) + EPS);
                u32x2* o8 = (u32x2*)(XB + (size_t)mr[r] * D) + lane;
#pragma unroll
                for (int j = 0; j < 4; ++j) { u32x2 w; w.x = cvt_pk_bf16(v[r][j][0], v[r][j][1]); w.y = cvt_pk_bf16(v[r][j][2], v[r][j][3]); o8[64 * j] = w; } }
        }
        for (int it = gw; it < 128 * 24; it += NGW) {
            const int b = it / 24, r = it % 24;
            bf16_t* zr = Z + (size_t)(MP + b * 32 + r) * DIN;
#pragma unroll
            for (int j = 0; j < 3; ++j) {
                const int c = lane * 8 + 512 * j; u32x4 w = {0u, 0u, 0u, 0u};
                const float* src = nullptr;
                if (j == 0 && r >= 21) src = args.in[I_SLC] + ((size_t)b * 3 + (r - 21)) * 512 + c;
                if (j == 2 && r >= 9) src = args.in[I_SPOOL] + ((size_t)b * 15 + (r - 9)) * 512 + (c - 1024);
                if (src) { const f32x4 a = *(const f32x4*)src, bq = *(const f32x4*)(src + 4); w.x = cvt_pk_bf16(a[0], a[1]); w.y = cvt_pk_bf16(a[2], a[3]); w.z = cvt_pk_bf16(bq[0], bq[1]); w.w = cvt_pk_bf16(bq[2], bq[3]); }
                *(u32x4*)(zr + c) = w;
            }
        }
        for (int i = gt; i < 128 * 7 * 512; i += NGT) { const int b = i / 3584, rem = i % 3584; out[O_SPOOL + (size_t)b * 7680 + rem] = args.in[I_SPOOL][(size_t)b * 7680 + 4096 + rem]; }
    }
    SEAM(0); STAMP(0);

    if (IN(1)) for (int rep_ = 0; rep_ < REPS(1); ++rep_) {
        if (rep_) xcd_barrier(bar);
        {
            const int nun = (M / 256) * (DIN / 256), first = nun - G;
            const int c0 = (first > 0 && first < G) ? first : 0, nhelp = G - c0;
            if ((int)blockIdx.x >= c0) {
                int tid = threadIdx.x; asm volatile("" : "+v"(tid)); const int lane = tid & 63, wave = __builtin_amdgcn_readfirstlane(tid >> 6);
                LAS float* scr = (LAS float*)(lds + wave * 16384);
                constexpr int I_WO = 16 * 32, I_WU = 16 * 192;
                for (int it = ((int)blockIdx.x - c0) * 8 + wave; it < I_WO + I_WU; it += nhelp * 8) {
                    if (it < I_WO) p0_transpose_item(args.in[I_WOUT], D, D, Wo_t, nullptr, false, scr, it, lane);
                    else p0_transpose_item(args.in[I_UP], D, FF2, Wu_t, args.in[I_G2], true, scr, it - I_WO, lane);
                }
            }
        }
        __syncthreads();
        pg8::Gemm g{XB, Wi_t, M, DIN, D, D}; pg8::StaticOrder S; S.init(M, DIN, G, (int)blockIdx.x);
        EpiZ E{Z, rs1};
        pg8::gemm_phase<EpiZ, pg8::StaticOrder, true, true>(lds, g, S, E);
    }
    SEAM(1); STAMP(1);

    if (IN(2)) for (int rep_ = 0; rep_ < REPS(2); ++rep_) {
        if (rep_) xcd_barrier(bar);
        TID_SETUP
        for (int ch = tid; ch < 8192; ch += 512) { const int row = ch >> 4, c = ch & 15, o = row & 127, key = ((o >> 3) & 3) * 4 + (o & 3);
            *(LAS u32x4*)(lds + row * 256 + ((c ^ key) << 4)) = *(const u32x4*)(PW_t + (size_t)row * 128 + c * 8); }
        __syncthreads();
        MixCtx C{Z, HP, SUMP, SUMH, MIX, args.in[I_PSC]};
        LAS float* KC = (LAS float*)(lds + LDS_X + wave * 2048);
        {
            const int i0 = (int)((long)gw * (8 * NBLK) / NGW), i1 = (int)((long)(gw + 1) * (8 * NBLK) / NGW);
            int curh = -1; bf16x8 WA[4][2], WX[4][2];
#pragma unroll
            for (int n = 0; n < 4; ++n)
#pragma unroll
                for (int k = 0; k < 2; ++k) { WA[n][k] = (bf16x8){0, 0, 0, 0, 0, 0, 0, 0}; WX[n][k] = WA[n][k]; }
            u32x4 zc[2], zq[2];
            zc[0] = zc[1] = zq[0] = zq[1] = (u32x4){0u, 0u, 0u, 0u};
            if (i0 < i1) lru_load(C, i0 / NBLK, i0 % NBLK, lane, zc, zq);
            for (int it = i0; it < i1; ++it) {
                const int h = it / NBLK, blk = it % NBLK;
                if (h != curh) {
                    curh = h;
                    asm volatile("s_waitcnt lgkmcnt(0)" ::: "memory");
                    const int ch = h * 64 + lane;
#pragma unroll
                    for (int t = 0; t < 4; ++t) KC[t * 64 + lane] = args.in[I_LCW][t * 512 + ch];
                    KC[256 + lane] = args.in[I_LCB][ch]; KC[320 + lane] = args.in[I_BA][ch]; KC[384 + lane] = args.in[I_BX][ch];
                    { const float lam = args.in[I_LAM][ch]; KC[448 + lane] = log1pf(expf(-lam)); }
                    const int rho = lane & 15, qq = lane >> 4;
#pragma unroll
                    for (int n = 0; n < 4; ++n) { const int o = (n >> 1) * 32 + (rho >> 2) * 8 + (n & 1) * 4 + (rho & 3);
#pragma unroll
                        for (int k = 0; k < 2; ++k) { WA[n][k] = *(const bf16x8*)(WA_t + (size_t)(h * 64 + o) * 64 + k * 32 + qq * 8); WX[n][k] = *(const bf16x8*)(WX_t + (size_t)(h * 64 + o) * 64 + k * 32 + qq * 8); } }
                    asm volatile("s_waitcnt lgkmcnt(0)" ::: "memory");
                }
                u32x4 nzc[2], nzq[2];
                if (it + 1 < i1) lru_load(C, (it + 1) / NBLK, (it + 1) % NBLK, lane, nzc, nzq);
                else { nzc[0] = nzc[1] = nzq[0] = nzq[1] = (u32x4){0u, 0u, 0u, 0u}; }
                lru_item(C, h, blk, WA, WX, KC, lane, zc, zq);
                zc[0] = nzc[0]; zc[1] = nzc[1]; zq[0] = nzq[0]; zq[1] = nzq[1];
            }
        }
        {
            const int gwr = NGW - 1 - gw;
            const int i0 = (int)((long)gwr * (4 * NBLK) / NGW), i1 = (int)((long)(gwr + 1) * (4 * NBLK) / NGW);
            u32x4 pc[4], pq[4];
#pragma unroll
            for (int ks = 0; ks < 4; ++ks) pc[ks] = pq[ks] = (u32x4){0u, 0u, 0u, 0u};
            if (i0 < i1) pool_load(C, i0 / NBLK, i0 % NBLK, lane, pc, pq);
            for (int it = i0; it < i1; ++it) {
                u32x4 npc[4], npq[4];
                if (it + 1 < i1) pool_load(C, (it + 1) / NBLK, (it + 1) % NBLK, lane, npc, npq);
                else {
#pragma unroll
                    for (int ks = 0; ks < 4; ++ks) npc[ks] = npq[ks] = (u32x4){0u, 0u, 0u, 0u}; }
                pool_item(C, it / NBLK, it % NBLK, lds, lane, pc, pq);
#pragma unroll
                for (int ks = 0; ks < 4; ++ks) { pc[ks] = npc[ks]; pq[ks] = npq[ks]; }
            }
        }
        __syncthreads();
    }
    SEAM(2); STAMP(2);

    if (IN(3)) for (int rep_ = 0; rep_ < REPS(3); ++rep_) {
        if (rep_) xcd_barrier(bar);
        TID_SETUP
        for (int id = gw; id < 2048 + 1024; id += NGW) {
            if (id < 2048) {
                const int b = id >> 8, ck = (id & 255) >> 3, c = (id & 7) * 64 + lane; const size_t base = (size_t)b * 2048;
                float carry = 0.f;
                for (int k0 = 0; k0 < 4 * ck; k0 += 32) {
                    float pa[32], ha[32];
#pragma unroll
                    for (int k = 0; k < 32; ++k) { const int kk = (k0 + k < 4 * ck) ? k0 + k : 0; const size_t o = ((size_t)b * 128 + kk) * DL + c; pa[k] = SUMP[o]; ha[k] = SUMH[o]; }
#pragma unroll
                    for (int k = 0; k < 32; ++k) if (k0 + k < 4 * ck) carry = pa[k] * carry + ha[k];
                }
                float h = 0.f;
#pragma unroll 1
                for (int t0 = 0; t0 < 64; t0 += 32) {
                    unsigned wa[32]; bf16_t za[32]; float sp[2], sh[2]; const size_t row0 = base + 64 * ck + t0;
#pragma unroll
                    for (int t = 0; t < 32; ++t) { wa[t] = __builtin_nontemporal_load(HP + (row0 + t) * DL + c); za[t] = __builtin_nontemporal_load(Z + (row0 + t) * DIN + 512 + c); }
#pragma unroll
                    for (int k = 0; k < 2; ++k) { const size_t o = ((row0 >> 4) + k) * DL + c; sp[k] = SUMP[o]; sh[k] = SUMH[o]; }
#pragma unroll
                    for (int t = 0; t < 32; ++t) {
                        if ((t & 15) == 15) { h = sh[t >> 4] + sp[t >> 4] * carry; } else { h = bf_lo(wa[t]) + bf_hi(wa[t]) * carry; }
                        MIX[(row0 + t) * D + c] = (bf16_t)(cvt_pk_bf16(h * gelu_tanh(bf_one(za[t])), 0.f) & 0xffffu);
                        if ((t & 15) == 15) carry = h; }
                }
                if (ck == 31) out[O_PH + b * 512 + c] = h;
            } else {
                const int sid = id - 2048, b = sid >> 3, c = (sid & 7) * 64 + lane;
                const float carry = args.in[I_SH][b * 512 + c]; float h = 0.f;
#pragma unroll
                for (int s = 0; s < 8; ++s) { const size_t zr = (size_t)MP + b * 32 + 24 + s;
                    if (s == 7) { const size_t so = (zr >> 4) * DL + c; h = SUMH[so] + SUMP[so] * carry; } else { const unsigned w = HP[zr * DL + c]; h = bf_lo(w) + bf_hi(w) * carry; }
                    const float zg = bf_one(Z[zr * DIN + 512 + c]);
                    MIX[((size_t)MP + b * 8 + s) * D + c] = (bf16_t)(cvt_pk_bf16(h * gelu_tanh(zg), 0.f) & 0xffffu); }
                out[O_SH + b * 512 + c] = h;
            }
        }
        for (int i = gt; i < 8 * 3 * 512; i += NGT) { const int b = i / 1536, k = (i % 1536) >> 9, c = i & 511; out[O_PLC + i] = bf_one(Z[((size_t)b * 2048 + 2045 + k) * DIN + c]); }
        for (int i = gt; i < 8 * 15 * 512; i += NGT) { const int b = i / 7680, k = (i % 7680) >> 9, c = i & 511; out[O_PPOOL + i] = bf_one(Z[((size_t)b * 2048 + 2033 + k) * DIN + 1024 + c]); }
        for (int i = gt; i < 128 * 3 * 512; i += NGT) { const int b = i / 1536, k = (i % 1536) >> 9, c = i & 511; out[O_SLC + i] = bf_one(Z[((size_t)MP + b * 32 + 29 + k) * DIN + c]); }
        for (int i = gt; i < 128 * 8 * 512; i += NGT) { const int b = i >> 12, s = (i >> 9) & 7, c = i & 511; out[O_SPOOL + (size_t)b * 7680 + (7 + s) * 512 + c] = bf_one(Z[((size_t)MP + b * 32 + 24 + s) * DIN + 1024 + c]); }
    }
    SEAM(3); STAMP(3);

    if (IN(4)) for (int rep_ = 0; rep_ < REPS(4); ++rep_) {
        if (rep_) xcd_barrier(bar);
        {
            const int c0 = 64 < G ? 64 : 0, nhelp = G - c0;
            if ((int)blockIdx.x >= c0) {
                int tid = threadIdx.x; asm volatile("" : "+v"(tid)); const int lane = tid & 63, wave = __builtin_amdgcn_readfirstlane(tid >> 6);
                LAS float* scr = (LAS float*)(lds + wave * 16384);
                for (int it = ((int)blockIdx.x - c0) * 8 + wave; it < 48 * 32; it += nhelp * 8) p0_transpose_item(args.in[I_DOWN], FF, D, Wd_t, nullptr, false, scr, it, lane);
            }
        }
        __syncthreads();
        { pg8::Gemm g{MIX, Wo_t, MP, D, D, D}; pg8::StaticOrder S; S.init(MP, D, G, (int)blockIdx.x);
          EpiX1 E{args.in[I_XP], args.in[I_XS], out + O_Y, XB, rss2};
          pg8::gemm_phase<EpiX1, pg8::StaticOrder, true, true>(lds, g, S, E); }
        { pg8::Gemm g{MIX, Wo_t, MS, D, D / 4, D}; pg8::SplitOrder S{G, (int)blockIdx.x, 4, D / 4};
          EpiPart E{part2, D / 4};
          pg8::gemm_phase<EpiPart, pg8::SplitOrder, true, true>(lds, g, S, E); }
    }
    SEAM(4); STAMP(4);

    if (IN(5)) for (int rep_ = 0; rep_ < REPS(5); ++rep_) {
        if (rep_) xcd_barrier(bar);
        unsigned* red_cnt = (unsigned*)ws + CW_RED;
        {
            int tid = threadIdx.x; asm volatile("" : "+v"(tid)); const int lane = tid & 63, wave = __builtin_amdgcn_readfirstlane(tid >> 6);
            for (int r = blockIdx.x * 8 + wave; r < MS; r += NGW) {
                const f32x4* xr = (const f32x4*)(args.in[I_XS] + (size_t)r * D) + lane; f32x4 v[4]; float s = 0.f;
#pragma unroll
                for (int j = 0; j < 4; ++j) v[j] = xr[64 * j];
#pragma unroll
                for (int ks = 0; ks < 4; ++ks) { const f32x4* pr = (const f32x4*)(part2 + ((size_t)ks * MS + r) * D) + lane;
#pragma unroll
                    for (int j = 0; j < 4; ++j) v[j] += __builtin_nontemporal_load(pr + 64 * j); }
#pragma unroll
                for (int j = 0; j < 4; ++j) s += (v[j][0] * v[j][0] + v[j][1] * v[j][1]) + (v[j][2] * v[j][2] + v[j][3] * v[j][3]);
                s = wave_sum(s);
                if (lane < 16) rss2[(size_t)(MP + r) * 16 + lane] = lane == 0 ? s : 0.f;
                u32x2* o8 = (u32x2*)(XB + (size_t)(MP + r) * D) + lane;
#pragma unroll
                for (int j = 0; j < 4; ++j) { u32x2 w; w.x = cvt_pk_bf16(v[j][0], v[j][1]); w.y = cvt_pk_bf16(v[j][2], v[j][3]); o8[64 * j] = w; }
            }
            (void)red_cnt;
        }
        pg8::Gemm g{XB, Wu_t, MP, FF2, D, D}; pg8::StaticOrder S; S.init(MP, FF2, G, (int)blockIdx.x);
        EpiFfn<false> E{ACT, rss2, args.in[I_FCW], args.in[I_FCB], args.in[I_SFFN], edge, out + O_PFFN, out + O_SFFN, lds + LDS_X};
        pg8::gemm_phase<EpiFfn<false>, pg8::StaticOrder, true, true>(lds, g, S, E);
    }
    SEAM(5); STAMP(5);

    if (IN(7)) for (int rep_ = 0; rep_ < REPS(7); ++rep_) {
        if (rep_) xcd_barrier(bar);
        unsigned* g3s_cnt = (unsigned*)ws + CW_G3S;
        {
            int tid = threadIdx.x; asm volatile("" : "+v"(tid));
            const int pm = 8 * ((int)blockIdx.x & 7) + (((int)blockIdx.x >> 3) & 7);
            if ((pm & 7) != 0) {
                const float* cw = args.in[I_FCW]; const float* cb = args.in[I_FCB];
                const float* L = edge + ((size_t)(pm - 1) * 4 + 2) * FF2; const float* F = edge + (size_t)pm * 4 * FF2;
                for (int f = tid * 4; f < FF; f += 2048) {
                    f32x4 a0, a1, v0, v1;
                    { const f32x4 l0 = *(const f32x4*)(L + f), l1 = *(const f32x4*)(L + FF2 + f), f0 = *(const f32x4*)(F + f), f1 = *(const f32x4*)(F + FF2 + f);
                      const f32x4 w0 = *(const f32x4*)(cw + f), w1 = *(const f32x4*)(cw + FF2 + f), w2 = *(const f32x4*)(cw + 2 * FF2 + f), bb = *(const f32x4*)(cb + f);
                      a0 = bb + w0 * l0 + w1 * l1 + w2 * f0; a1 = bb + w0 * l1 + w1 * f0 + w2 * f1; }
                    { const int fv = FF + f; const f32x4 l0 = *(const f32x4*)(L + fv), l1 = *(const f32x4*)(L + FF2 + fv), f0 = *(const f32x4*)(F + fv), f1 = *(const f32x4*)(F + FF2 + fv);
                      const f32x4 w0 = *(const f32x4*)(cw + fv), w1 = *(const f32x4*)(cw + FF2 + fv), w2 = *(const f32x4*)(cw + 2 * FF2 + fv), bb = *(const f32x4*)(cb + fv);
                      v0 = bb + w0 * l0 + w1 * l1 + w2 * f0; v1 = bb + w0 * l1 + w1 * f0 + w2 * f1; }
                    u32x2 o0, o1;
                    o0.x = cvt_pk_bf16(gelu_tanh(a0[0]) * v0[0], gelu_tanh(a0[1]) * v0[1]); o0.y = cvt_pk_bf16(gelu_tanh(a0[2]) * v0[2], gelu_tanh(a0[3]) * v0[3]);
                    o1.x = cvt_pk_bf16(gelu_tanh(a1[0]) * v1[0], gelu_tanh(a1[1]) * v1[1]); o1.y = cvt_pk_bf16(gelu_tanh(a1[2]) * v1[2], gelu_tanh(a1[3]) * v1[3]);
                    *(u32x2*)(ACT + (size_t)(pm * 256) * FF + f) = o0;
                    *(u32x2*)(ACT + (size_t)(pm * 256 + 1) * FF + f) = o1;
                }
            }
            asm volatile("s_waitcnt vmcnt(0)" ::: "memory"); __syncthreads();
        }
        const int cb = (int)blockIdx.x, loc = cb >> 3, l8 = loc & 7;
        const int rankA = l8 < 3 ? (cb & 7) + 8 * ((loc >> 3) * 3 + l8) : -1, rankB = l8 >= 3 ? (cb & 7) + 8 * ((loc >> 3) * 5 + (l8 - 3)) : -1;
        {
            pg8::Gemm g{XB, Wu_t, M, FF2, D, D}; pg8::SampleFfnOrder S{rankA, G};
            EpiFfn<true> E{ACT, rss2, args.in[I_FCW], args.in[I_FCB], args.in[I_SFFN], edge, out + O_PFFN, out + O_SFFN, lds + LDS_X};
            pg8::gemm_phase<EpiFfn<true>, pg8::SampleFfnOrder, true, true>(lds, g, S, E);
            asm volatile("s_waitcnt vmcnt(0)" ::: "memory"); __syncthreads();
            if (rankA >= 0 && threadIdx.x == 0) { __builtin_amdgcn_fence(__ATOMIC_RELEASE, "agent"); asm volatile("s_waitcnt vmcnt(0)" ::: "memory"); __hip_atomic_fetch_add(g3s_cnt, 1u, __ATOMIC_RELAXED, __HIP_MEMORY_SCOPE_AGENT); }
        }
        { pg8::Gemm g{ACT, Wd_t, MP, D, FF, FF}; pg8::StaticOrder S; S.init(MP, D, G, (int)blockIdx.x);
          EpiX2N E{out + O_Y, XB, args.in[I_GF], (float*)(ws + WS_XS), (unsigned*)ws + CW_PAN, lds + LDS_X};
          pg8::gemm_phase<EpiX2N, pg8::StaticOrder, true, true>(lds, g, S, E); }
        { pg8::Gemm g{ACT, Wd_t, MS, D, FF / KSPLIT, FF}; pg8::GatedSplitOrder S{rankB, G, KSPLIT, FF / KSPLIT, g3s_cnt, 96u};
          EpiPart E{part, FF / KSPLIT};
          pg8::gemm_phase<EpiPart, pg8::GatedSplitOrder, true, true>(lds, g, S, E); }
    }
    SEAM(7); STAMP(7);

    if (IN(8)) for (int rep_ = 0; rep_ < REPS(8); ++rep_) {
        if (rep_) xcd_barrier(bar);
        TID_SETUP
        f32x4 gf[4];
#pragma unroll
        for (int j = 0; j < 4; ++j) gf[j] = ((const f32x4*)args.in[I_GF])[lane + 64 * j];
        for (int m = MP + gw; m < M; m += NGW) {
            f32x4* yr = (f32x4*)(out + O_Y + (size_t)m * D) + lane; f32x4 v[4]; float s = 0.f;
            if (m < MP) {
#pragma unroll
                for (int j = 0; j < 4; ++j) v[j] = yr[64 * j];
            } else {
                const u32x2* xb = (const u32x2*)(XB + (size_t)m * D) + lane;
#pragma unroll
                for (int j = 0; j < 4; ++j) { const u32x2 w = xb[64 * j]; v[j] = (f32x4){bf_lo(w.x), bf_hi(w.x), bf_lo(w.y), bf_hi(w.y)}; }
#pragma unroll
                for (int ks = 0; ks < KSPLIT; ++ks) { const f32x4* pr = (const f32x4*)(part + ((size_t)ks * MS + (m - MP)) * D) + lane;
#pragma unroll
                    for (int j = 0; j < 4; ++j) v[j] += pr[64 * j]; }
            }
#pragma unroll
            for (int j = 0; j < 4; ++j) s += (v[j][0] * v[j][0] + v[j][1] * v[j][1]) + (v[j][2] * v[j][2] + v[j][3] * v[j][3]);
            s = wave_sum(s); const float rstd = rsqrtf(s * (1.0f / D) + EPS);
#pragma unroll
            for (int j = 0; j < 4; ++j) yr[64 * j] = v[j] * rstd * gf[j];
        }
    }
    STAMP(8);
    if (TS_PHASE >= 0 && blockIdx.x == 0 && threadIdx.x == 0) out[O_Y] += (float)(ts1_ - ts0_) * 0.01f / TS_DIV;
#undef IN
#undef SEAM
}

extern "C" void kernel_launch(void* const* d_in, const int* in_sizes, int n_in, void* d_out, int out_size, void* d_ws, size_t ws_size, hipStream_t stream) {
    static int grid = 0;
    if (grid == 0) {
        if (n_in != 24 || ws_size < WS_END) { fprintf(stderr, "kernel_launch: unexpected n_in %d / ws %zu\n", n_in, ws_size); grid = -1; return; }
        int dev = 0, cus = 0, per_cu = 0;
        if (hipGetDevice(&dev) != hipSuccess || hipDeviceGetAttribute(&cus, hipDeviceAttributeMultiprocessorCount, dev) != hipSuccess) { grid = -1; return; }
        if (hipFuncSetAttribute((const void*)fwd_kernel, hipFuncAttributeMaxDynamicSharedMemorySize, LDS_BYTES) != hipSuccess) { fprintf(stderr, "kernel_launch: hipFuncSetAttribute failed\n"); grid = -1; return; }
        if (hipOccupancyMaxActiveBlocksPerMultiprocessor(&per_cu, (const void*)fwd_kernel, 512, LDS_BYTES) != hipSuccess || per_cu < 1) { fprintf(stderr, "kernel_launch: occupancy query says %d\n", per_cu); (void)hipGetLastError(); per_cu = 1; }
        if (cus != 256) { fprintf(stderr, "kernel_launch: built for a 256-CU device (one workgroup per CU; the fused final norm pairs 4 workgroups per row panel), found %d CUs; nothing launched\n", cus); grid = -1; return; }
        grid = cus * 1;
    }
    if (grid < 0) return;
    Args a{};
    for (int i = 0; i < 24; ++i) a.in[i] = (const float*)d_in[i];
    a.out = (float*)d_out; a.ws = (unsigned char*)d_ws;
    if (hipMemsetAsync(d_ws, 0, 65536, stream) != hipSuccess) { fprintf(stderr, "kernel_launch: memset failed\n"); return; }
#if MK_N_LAUNCHES == 1
    a.ph_lo = 0; a.ph_hi = 9;
    void* kargs[] = {&a};
    hipError_t e = hipLaunchCooperativeKernel((const void*)fwd_kernel, dim3(grid), dim3(512), kargs, LDS_BYTES, stream);
    if (e != hipSuccess) fprintf(stderr, "cooperative launch failed: %s (grid %d)\n", hipGetErrorString(e), grid);
#else
    for (int p = 0; p < 9; ++p) { a.ph_lo = p; a.ph_hi = p + 1; hipLaunchKernelGGL(fwd_kernel, dim3(grid), dim3(512), LDS_BYTES, stream, a); }
#endif
}
```
